# Optimizing an MI355X kernel written in HIP

```python
import math
import jax, jax.numpy as jnp
from jax import lax
import numpy as np

D_MODEL = 1024
BATCH = 16
SEQ = 2048
DEPTH = 4

N_MIXERS = 3
N_HEADS = 8
HEAD_DIM = 128
WIDTH = N_HEADS * HEAD_DIM
ROPE_THETA = 10000.0
NORM_EPS = 1e-6
Q_BLOCK = 128
MOBA_BLOCK = 256
MOBA_TOPK = 3
MOBA_Q_CHUNK = 8
DIFF_SUB_DIM = HEAD_DIM // 2
DIFF_LAMBDA_STD = 0.1

kernel_name = "hybrid_moba_fox_diffattn_gated"


def _layers_of(kind):
    return len(range(kind, DEPTH, N_MIXERS))


def rms_norm(x, g):
    x32 = x.astype(jnp.float32)
    y = x32 * lax.rsqrt(jnp.mean(x32 * x32, axis=-1, keepdims=True) + NORM_EPS)
    return (y * g.astype(jnp.float32)).astype(x.dtype)


def rope_tables(seq, dim):
    inv = 1.0 / (ROPE_THETA ** (jnp.arange(0, dim, 2, dtype=jnp.float32) / dim))
    ang = jnp.arange(seq, dtype=jnp.float32)[:, None] * inv[None, :]
    return jnp.cos(ang), jnp.sin(ang)


def apply_rope(x, cos, sin):
    x32 = x.astype(jnp.float32)
    x1, x2 = jnp.split(x32, 2, axis=-1)
    out = jnp.concatenate([x1 * cos - x2 * sin, x2 * cos + x1 * sin], axis=-1)
    return out.astype(x.dtype)


def split_heads(t, n):
    b, s, _ = t.shape
    return t.reshape(b, s, n, -1).transpose(0, 2, 1, 3)


def merge_heads(t):
    b, h, s, d = t.shape
    return t.transpose(0, 2, 1, 3).reshape(b, s, h * d)


def gather_blocks(blocks, idx):
    return jax.vmap(jax.vmap(lambda bl, ix: bl[ix]))(blocks, idx)


def moba_attention(q, k, v):
    b, h, s, d = q.shape
    nb = -(-s // MOBA_BLOCK)
    pad = nb * MOBA_BLOCK - s
    kb = jnp.pad(k, ((0, 0), (0, 0), (0, pad), (0, 0))).reshape(b, h, nb, MOBA_BLOCK, d)
    vb = jnp.pad(v, ((0, 0), (0, 0), (0, pad), (0, 0))).reshape(b, h, nb, MOBA_BLOCK, d)
    topk = min(MOBA_TOPK, nb - 1)
    scale = d ** -0.5
    if topk > 0:
        k_mean = jnp.mean(kb.astype(jnp.float32), axis=3)
        gate = jnp.einsum('bhsd,bhnd->bhsn', q, k_mean.astype(q.dtype),
                          preferred_element_type=jnp.float32)
        q_blk = jnp.arange(s) // MOBA_BLOCK
        past = jnp.arange(nb)[None, :] < q_blk[:, None]
        gate = jnp.where(past, gate, -jnp.inf)
        _, sel = lax.top_k(gate, topk)

    def chunk(c):
        t0 = c * MOBA_Q_CHUNK
        qc = lax.dynamic_slice_in_dim(q, t0, MOBA_Q_CHUNK, axis=2)
        tq = t0 + jnp.arange(MOBA_Q_CHUNK)
        own = t0 // MOBA_BLOCK
        k_own = lax.dynamic_index_in_dim(kb, own, axis=2, keepdims=False)
        v_own = lax.dynamic_index_in_dim(vb, own, axis=2, keepdims=False)
        s_own = jnp.einsum('bhqd,bhkd->bhqk', qc, k_own,
                           preferred_element_type=jnp.float32) * scale
        kpos = own * MOBA_BLOCK + jnp.arange(MOBA_BLOCK)
        s_own = jnp.where(kpos[None, :] <= tq[:, None], s_own, -jnp.inf)
        if topk == 0:
            p_own = jax.nn.softmax(s_own, axis=-1)
            return jnp.einsum('bhqk,bhkd->bhqd', p_own.astype(v.dtype), v_own)
        sel_c = lax.dynamic_slice_in_dim(sel, t0, MOBA_Q_CHUNK, axis=2)
        k_sel = gather_blocks(kb, sel_c)
        v_sel = gather_blocks(vb, sel_c)
        s_sel = jnp.einsum('bhqd,bhqnkd->bhqnk', qc, k_sel,
                           preferred_element_type=jnp.float32) * scale
        valid = sel_c < own
        s_sel = jnp.where(valid[..., None], s_sel, -jnp.inf)
        s_sel = s_sel.reshape(b, h, MOBA_Q_CHUNK, topk * MOBA_BLOCK)
        p = jax.nn.softmax(jnp.concatenate([s_sel, s_own], axis=-1), axis=-1).astype(v.dtype)
        p_sel = p[..., :topk * MOBA_BLOCK].reshape(b, h, MOBA_Q_CHUNK, topk, MOBA_BLOCK)
        p_own = p[..., topk * MOBA_BLOCK:]
        return (jnp.einsum('bhqnk,bhqnkd->bhqd', p_sel, v_sel)
                + jnp.einsum('bhqk,bhkd->bhqd', p_own, v_own))

    outs = lax.map(chunk, jnp.arange(s // MOBA_Q_CHUNK))
    return outs.transpose(1, 2, 0, 3, 4).reshape(b, h, s, d)


def forgetting_attention(q, k, v, log_f):
    b, h, s, d = q.shape
    scale = d ** -0.5
    c = jnp.cumsum(log_f, axis=-1)
    kpos = jnp.arange(s)

    def block(i):
        t0 = i * Q_BLOCK
        qb = lax.dynamic_slice_in_dim(q, t0, Q_BLOCK, axis=2)
        cq = lax.dynamic_slice_in_dim(c, t0, Q_BLOCK, axis=2)
        tq = t0 + jnp.arange(Q_BLOCK)
        sc = (jnp.einsum('bhqd,bhkd->bhqk', qb, k, preferred_element_type=jnp.float32) * scale
              + (cq[..., :, None] - c[..., None, :]))
        sc = jnp.where(kpos[None, :] <= tq[:, None], sc, -jnp.inf)
        p = jax.nn.softmax(sc, axis=-1)
        return jnp.einsum('bhqk,bhkd->bhqd', p.astype(v.dtype), v)

    outs = lax.map(block, jnp.arange(s // Q_BLOCK))
    return outs.transpose(1, 2, 0, 3, 4).reshape(b, h, s, d)


def differential_attention(q1, q2, k1, k2, v, lam):
    b, h, s, d = q1.shape
    scale = d ** -0.5
    kpos = jnp.arange(s)

    def block(i):
        t0 = i * Q_BLOCK
        tq = t0 + jnp.arange(Q_BLOCK)
        mask = kpos[None, :] <= tq[:, None]
        qb1 = lax.dynamic_slice_in_dim(q1, t0, Q_BLOCK, axis=2)
        qb2 = lax.dynamic_slice_in_dim(q2, t0, Q_BLOCK, axis=2)
        s1 = jnp.einsum('bhqd,bhkd->bhqk', qb1, k1, preferred_element_type=jnp.float32) * scale
        s2 = jnp.einsum('bhqd,bhkd->bhqk', qb2, k2, preferred_element_type=jnp.float32) * scale
        p = (jax.nn.softmax(jnp.where(mask, s1, -jnp.inf), axis=-1)
             - lam * jax.nn.softmax(jnp.where(mask, s2, -jnp.inf), axis=-1))
        return jnp.einsum('bhqk,bhkd->bhqd', p.astype(v.dtype), v)

    outs = lax.map(block, jnp.arange(s // Q_BLOCK))
    return outs.transpose(1, 2, 0, 3, 4).reshape(b, h, s, v.shape[-1])


def setup_inputs(seed: int = 0) -> dict:
    key = jax.random.key(seed)
    ks = jax.random.split(key, 20)
    na, nbl, nc = _layers_of(0), _layers_of(1), _layers_of(2)
    f32 = jnp.float32
    w_in_scale = D_MODEL ** -0.5
    w_out_scale = WIDTH ** -0.5

    def gain(k, shape):
        return 1.0 + 0.02 * jax.random.normal(k, shape, f32)

    return {
        "x": jax.random.normal(ks[0], (BATCH, SEQ, D_MODEL), f32),
        "norm_g": gain(ks[1], (DEPTH, D_MODEL)),
        "w_out": jax.random.normal(ks[2], (DEPTH, WIDTH, D_MODEL), f32) * w_out_scale,
        "a_w_in": jax.random.normal(ks[3], (na, D_MODEL, 4 * WIDTH), f32) * w_in_scale,
        "a_q_norm": gain(ks[4], (na, HEAD_DIM)),
        "a_k_norm": gain(ks[5], (na, HEAD_DIM)),
        "b_w_in": jax.random.normal(ks[6], (nbl, D_MODEL, 4 * WIDTH + N_HEADS), f32) * w_in_scale,
        "b_f_bias": jax.random.uniform(ks[7], (nbl, N_HEADS), f32, minval=1.0, maxval=4.0),
        "b_q_norm": gain(ks[8], (nbl, HEAD_DIM)),
        "b_k_norm": gain(ks[9], (nbl, HEAD_DIM)),
        "c_w_in": jax.random.normal(ks[10], (nc, D_MODEL, 4 * WIDTH), f32) * w_in_scale,
        "c_q_norm": gain(ks[11], (nc, DIFF_SUB_DIM)),
        "c_k_norm": gain(ks[12], (nc, DIFF_SUB_DIM)),
        "c_lambda_q1": DIFF_LAMBDA_STD * jax.random.normal(ks[13], (nc, DIFF_SUB_DIM), f32),
        "c_lambda_k1": DIFF_LAMBDA_STD * jax.random.normal(ks[14], (nc, DIFF_SUB_DIM), f32),
        "c_lambda_q2": DIFF_LAMBDA_STD * jax.random.normal(ks[15], (nc, DIFF_SUB_DIM), f32),
        "c_lambda_k2": DIFF_LAMBDA_STD * jax.random.normal(ks[16], (nc, DIFF_SUB_DIM), f32),
        "c_subln": gain(ks[17], (nc, HEAD_DIM)),
    }


def reference(x, norm_g, w_out, a_w_in, a_q_norm, a_k_norm, b_w_in, b_f_bias, b_q_norm, b_k_norm,
              c_w_in, c_q_norm, c_k_norm, c_lambda_q1, c_lambda_k1, c_lambda_q2, c_lambda_k2, c_subln):
    b, s, _ = x.shape
    cos_h, sin_h = rope_tables(s, HEAD_DIM)
    cos_d, sin_d = rope_tables(s, DIFF_SUB_DIM)
    for i in range(DEPTH):
        kind = i % N_MIXERS
        j = i // N_MIXERS
        hdn = rms_norm(x, norm_g[i])
        if kind == 0:
            proj = hdn @ a_w_in[j]
            q, k, v, z = jnp.split(proj, 4, axis=-1)
            q = apply_rope(rms_norm(split_heads(q, N_HEADS), a_q_norm[j]), cos_h, sin_h)
            k = apply_rope(rms_norm(split_heads(k, N_HEADS), a_k_norm[j]), cos_h, sin_h)
            y = moba_attention(q, k, split_heads(v, N_HEADS))
        elif kind == 1:
            proj = hdn @ b_w_in[j]
            q, k, v, z = jnp.split(proj[..., :4 * WIDTH], 4, axis=-1)
            f_logit = (proj[..., 4 * WIDTH:] + b_f_bias[j]).astype(jnp.float32)
            log_f = jax.nn.log_sigmoid(f_logit).transpose(0, 2, 1)
            q = rms_norm(split_heads(q, N_HEADS), b_q_norm[j])
            k = rms_norm(split_heads(k, N_HEADS), b_k_norm[j])
            y = forgetting_attention(q, k, split_heads(v, N_HEADS), log_f)
        else:
            proj = hdn @ c_w_in[j]
            q, k, v, z = jnp.split(proj, 4, axis=-1)
            q = q.reshape(b, s, N_HEADS, 2, DIFF_SUB_DIM).transpose(0, 2, 3, 1, 4)
            k = k.reshape(b, s, N_HEADS, 2, DIFF_SUB_DIM).transpose(0, 2, 3, 1, 4)
            q = apply_rope(rms_norm(q, c_q_norm[j]), cos_d, sin_d)
            k = apply_rope(rms_norm(k, c_k_norm[j]), cos_d, sin_d)
            lambda_init = 0.8 - 0.6 * math.exp(-0.3 * i)
            lam = (jnp.exp(jnp.sum(c_lambda_q1[j] * c_lambda_k1[j]).astype(jnp.float32))
                   - jnp.exp(jnp.sum(c_lambda_q2[j] * c_lambda_k2[j]).astype(jnp.float32))
                   + lambda_init)
            y = differential_attention(q[:, :, 0], q[:, :, 1], k[:, :, 0], k[:, :, 1],
                                       split_heads(v, N_HEADS), lam)
            y = rms_norm(y, c_subln[j]) * (1.0 - lambda_init)
        y = merge_heads(y) * jax.nn.silu(z)
        x = x + y @ w_out[i]
    return x
```

```cpp
#include <hip/hip_runtime.h>
#include <hip/hip_cooperative_groups.h>
#include <cstdio>
#include <cstdint>
namespace cg = cooperative_groups;

#define DI __device__ __forceinline__
typedef short bf16x8 __attribute__((ext_vector_type(8)));
typedef float f32x16 __attribute__((ext_vector_type(16)));
typedef __bf16 bf2_t __attribute__((ext_vector_type(2)));
typedef float f2_t __attribute__((ext_vector_type(2)));
typedef unsigned short bf16;
typedef unsigned u32x4 __attribute__((ext_vector_type(4)));
typedef float f32x4 __attribute__((ext_vector_type(4)));
#define LAS __attribute__((address_space(3)))

#define MFMA32(a, b, c) __builtin_amdgcn_mfma_f32_32x32x16_bf16((a), (b), (c), 0, 0, 0)

constexpr int kB = 16, kS = 2048, kD = 1024, kH = 8, kM = kB * kS, kNPAD = 4224;
constexpr float kEps = 1e-6f, kLog2e = 1.4426950408889634f;
constexpr float kNeg = -1e30f;

constexpr size_t SZ_ACT    = (size_t)kM * 1024 * 2;
constexpr size_t OFF_WTIN  = 0;
constexpr size_t OFF_WTOUT = OFF_WTIN + (size_t)4 * kNPAD * 1024 * 2;
constexpr size_t OFF_XB    = OFF_WTOUT + (size_t)4 * 1024 * 1024 * 2;
constexpr size_t OFF_Q     = OFF_XB + SZ_ACT;
constexpr size_t OFF_K     = OFF_Q + SZ_ACT;
constexpr size_t OFF_VT    = OFF_K + SZ_ACT;
constexpr size_t OFF_G     = OFF_VT + SZ_ACT;
constexpr size_t OFF_Y     = OFF_G + SZ_ACT;
constexpr size_t OFF_ROWSQ = OFF_Y + SZ_ACT;
constexpr size_t OFF_KPART = OFF_ROWSQ + (size_t)32 * kM * 4;
constexpr size_t OFF_LOGF  = OFF_KPART + (size_t)128 * 16 * 128 * 4;
constexpr size_t OFF_COSH  = OFF_LOGF + (size_t)128 * 2048 * 4;
constexpr size_t OFF_SINH  = OFF_COSH + (size_t)2048 * 64 * 4;
constexpr size_t OFF_COSD  = OFF_SINH + (size_t)2048 * 64 * 4;
constexpr size_t OFF_SIND  = OFF_COSD + (size_t)2048 * 32 * 4;
constexpr size_t OFF_LAM   = OFF_SIND + (size_t)2048 * 32 * 4;
constexpr size_t OFF_CONST = OFF_LAM + 256;
constexpr size_t OFF_BAR   = OFF_CONST + 8192;
constexpr size_t WS_NEED   = OFF_BAR + 16384;

constexpr int SMEM_BYTES = 152576;
constexpr int NTHR = 512;

struct Params {
  const float* x; const float* norm_g; const float* w_out;
  const float* a_w_in; const float* a_q_norm; const float* a_k_norm;
  const float* b_w_in; const float* b_f_bias; const float* b_q_norm; const float* b_k_norm;
  const float* c_w_in; const float* c_q_norm; const float* c_k_norm;
  const float* c_lq1; const float* c_lk1; const float* c_lq2; const float* c_lk2; const float* c_subln;
  float* out; unsigned char* ws;
};

DI unsigned pk2(float a, float b) { f2_t f = {a, b}; bf2_t r = __builtin_convertvector(f, bf2_t); return __builtin_bit_cast(unsigned, r); }
DI float bf_lo(unsigned u) { return __uint_as_float(u << 16); }
DI float bf_hi(unsigned u) { return __uint_as_float(u & 0xffff0000u); }
DI float wave_sum(float v) {
#pragma unroll
  for (int o = 32; o; o >>= 1) v += __shfl_xor(v, o);
  return v;
}


#define XB_TMO      128
#define XB_XCNT(j)  (256  + 64 * (j))
#define XB_XSUB(j)  (1280 + 64 * (j))
#define XB_XGEN(j)  (2304 + 64 * (j))
#define XB_TOP      3328
#define XB_TOPGEN   3392
#define XCD_BAR_WORDS 3456
#define XB_SPIN_CAP (1u << 18)

__device__ __forceinline__ unsigned xb_ld(unsigned* p)              { return __hip_atomic_load(p, __ATOMIC_RELAXED, __HIP_MEMORY_SCOPE_AGENT); }
__device__ __forceinline__ unsigned xb_add(unsigned* p, unsigned v) { return __hip_atomic_fetch_add(p, v, __ATOMIC_RELAXED, __HIP_MEMORY_SCOPE_AGENT); }
__device__ __forceinline__ unsigned xb_xcc_id() { return (unsigned)__builtin_amdgcn_s_getreg((3 << 11) | 20) & 0xFu; }
#define XB_SPIN(cond, bar) do { unsigned _sp = 0; while (cond) { __builtin_amdgcn_s_sleep(1); \
    if ((++_sp & 255u) == 0u) { if (xb_ld(&(bar)[XB_TMO])) break; if (_sp > XB_SPIN_CAP) { atomicAdd(&(bar)[XB_TMO], 1u); break; } } } } while (0)

struct XcdBarrier {
    unsigned* bar; unsigned x;
    volatile LAS unsigned* st;
};

__device__ __forceinline__ XcdBarrier xcd_barrier_post(unsigned* bar, volatile LAS unsigned* st) {
    XcdBarrier b; b.bar = bar; b.x = xb_xcc_id(); b.st = st;
    if (threadIdx.x == 0) (void)xb_add(&bar[XB_XCNT(b.x)], 1u);
    return b;
}
__device__ __forceinline__ void xcd_barrier_complete(unsigned* bar, unsigned x, unsigned& nloc, unsigned& nx) {
    const unsigned G = gridDim.x * gridDim.y * gridDim.z;
    unsigned sum, cnt, mine, sp = 0u;
    for (;;) {
        sum = 0u; cnt = 0u; mine = 0u;
#pragma unroll
        for (unsigned j = 0; j < 16; ++j) { const unsigned c = xb_ld(&bar[XB_XCNT(j)]); sum += c; cnt += (c > 0u) ? 1u : 0u; mine = (j == x) ? c : mine; }
        if (sum == G) break;
        __builtin_amdgcn_s_sleep(1);
        if ((++sp & 255u) == 0u) { if (xb_ld(&bar[XB_TMO])) break; if (sp > XB_SPIN_CAP) { atomicAdd(&bar[XB_TMO], 1u); break; } }
    }
    nloc = mine > 0u ? mine : 1u; nx = cnt > 0u ? cnt : 1u;
}

__device__ __forceinline__ void xcd_barrier(const XcdBarrier& b) {
    asm volatile("s_waitcnt vmcnt(0)" ::: "memory");
    __syncthreads();
    if (threadIdx.x == 0) {
        unsigned* bar = b.bar;
        __builtin_amdgcn_s_waitcnt(0);
        unsigned nloc = b.st[0], nx = b.st[1];
        if (nloc == 0u) { xcd_barrier_complete(bar, b.x, nloc, nx); b.st[0] = nloc; b.st[1] = nx; }
        const unsigned old = xb_add(&bar[XB_XSUB(b.x)], 1u);
        const unsigned gen = old / nloc;
        if (old + 1u == (gen + 1u) * nloc) {
            __builtin_amdgcn_fence(__ATOMIC_RELEASE, "agent");
            asm volatile("s_waitcnt vmcnt(0)" ::: "memory");
            const unsigned og = xb_add(&bar[XB_TOP], 1u);
            const unsigned tg = og / nx;
            if (og + 1u == (tg + 1u) * nx) xb_add(&bar[XB_TOPGEN], 1u);
            else XB_SPIN(xb_ld(&bar[XB_TOPGEN]) == tg, bar);
            __builtin_amdgcn_fence(__ATOMIC_ACQUIRE, "agent");
            xb_add(&bar[XB_XGEN(b.x)], 1u);
            asm volatile("s_waitcnt vmcnt(0)" ::: "memory");
        } else {
            XB_SPIN(xb_ld(&bar[XB_XGEN(b.x)]) == gen, bar);
            __builtin_amdgcn_fence(__ATOMIC_ACQUIRE, "agent");
            asm volatile("s_waitcnt vmcnt(0)" ::: "memory");
        }
    }
    __syncthreads();
}

DI int opaque_tid() { int t = threadIdx.x; asm volatile("" : "+v"(t)); return t; }

DI void phase_prep(const Params& p, unsigned char* smem) {
  const int t = threadIdx.x, lane = t & 63;
  float* tl = (float*)smem;
  const int n_in_tiles = 4 * 16 * 66, n_tiles = n_in_tiles + 4 * 16 * 16;
  for (int tile = blockIdx.x; tile < n_tiles; tile += gridDim.x) {
    const float* W; const float* g; int N, kt, nt; bf16* WT;
    if (tile < n_in_tiles) {
      const int l = tile / 1056, rem = tile % 1056; kt = rem / 66; nt = rem % 66;
      W = (l == 0) ? p.a_w_in : (l == 1) ? p.b_w_in : (l == 2) ? p.c_w_in : p.a_w_in + (size_t)1024 * 4096;
      N = (l == 1) ? 4104 : 4096;
      g = p.norm_g + l * 1024;
      WT = (bf16*)(p.ws + OFF_WTIN) + (size_t)l * kNPAD * 1024;
    } else {
      const int t2 = tile - n_in_tiles; const int l = t2 / 256, rem = t2 % 256; kt = rem / 16; nt = rem % 16;
      W = p.w_out + (size_t)l * 1024 * 1024; N = 1024; g = nullptr;
      WT = (bf16*)(p.ws + OFF_WTOUT) + (size_t)l * 1024 * 1024;
    }
    {
      const int nl = t & 63, n = nt * 64 + nl;
      float wv[8], gv[8];
#pragma unroll
      for (int i = 0; i < 8; ++i) {
        const int k = kt * 64 + i * 8 + (t >> 6);
        wv[i] = (n < N) ? W[(size_t)k * N + n] : 0.f;
        gv[i] = g ? g[k] : 1.f;
      }
#pragma unroll
      for (int i = 0; i < 8; ++i) tl[(i * 8 + (t >> 6)) * 65 + nl] = wv[i] * gv[i];
    }
    __syncthreads();
    {
      const int nl = t >> 3, kc = (t & 7) * 8;
      unsigned u[4];
#pragma unroll
      for (int j = 0; j < 4; ++j) u[j] = pk2(tl[(kc + 2 * j) * 65 + nl], tl[(kc + 2 * j + 1) * 65 + nl]);
      *(uint4*)(WT + (size_t)(nt * 64 + nl) * 1024 + kt * 64 + kc) = make_uint4(u[0], u[1], u[2], u[3]);
    }
    __syncthreads();
  }
  {
    bf16* xb = (bf16*)(p.ws + OFF_XB);
    float* rowsq = (float*)(p.ws + OFF_ROWSQ);
    const int gw = blockIdx.x * 8 + (t >> 6), nw = gridDim.x * 8;
    for (int row0 = gw * 4; row0 < kM; row0 += nw * 4) {
      float4 v[4][4];
#pragma unroll
      for (int rr = 0; rr < 4; ++rr)
#pragma unroll
        for (int i = 0; i < 4; ++i) v[rr][i] = ((const float4*)(p.x + (size_t)(row0 + rr) * 1024))[i * 64 + lane];
#pragma unroll
      for (int rr = 0; rr < 4; ++rr) {
        uint2* xo = (uint2*)(xb + (size_t)(row0 + rr) * 1024);
        float ss = 0.f;
#pragma unroll
        for (int i = 0; i < 4; ++i) {
          const float4 q = v[rr][i];
          ss += q.x * q.x + q.y * q.y + q.z * q.z + q.w * q.w;
          xo[i * 64 + lane] = make_uint2(pk2(q.x, q.y), pk2(q.z, q.w));
        }
        ss = wave_sum(ss);
        if (lane < 32) rowsq[(size_t)lane * kM + row0 + rr] = (lane == 0) ? ss : 0.f;
      }
    }
  }
  {
    float* cosh_ = (float*)(p.ws + OFF_COSH); float* sinh_ = (float*)(p.ws + OFF_SINH);
    float* cosd_ = (float*)(p.ws + OFF_COSD); float* sind_ = (float*)(p.ws + OFF_SIND);
    const int tot = 2048 * 64 + 2048 * 32;
    for (int idx = blockIdx.x * NTHR + t; idx < tot; idx += gridDim.x * NTHR) {
      int pos, fi, half; float* cd; float* sd;
      if (idx < 2048 * 64) { pos = idx >> 6; fi = idx & 63; half = 64; cd = cosh_ + idx; sd = sinh_ + idx; }
      else { const int j = idx - 2048 * 64; pos = j >> 5; fi = j & 31; half = 32; cd = cosd_ + j; sd = sind_ + j; }
      const float inv = (float)exp(-9.210340371976184 * (double)fi / (double)half);
      const float ang = (float)pos * inv;
      const double tt = (double)ang * 0.15915494309189535;
      const double fr = tt - rint(tt);
      const float rr = (float)(fr * 6.283185307179586);
      *cd = cosf(rr); *sd = sinf(rr);
    }
  }
  if (blockIdx.x == 1 && t < 128) {
    float* cst = (float*)(p.ws + OFF_CONST);
    cst[0 * 256 + t] = p.a_q_norm[t];        cst[0 * 256 + 128 + t] = p.a_k_norm[t];
    cst[1 * 256 + t] = p.b_q_norm[t];        cst[1 * 256 + 128 + t] = p.b_k_norm[t];
    cst[2 * 256 + t] = p.c_q_norm[t & 63];   cst[2 * 256 + 128 + t] = p.c_k_norm[t & 63];
    cst[3 * 256 + t] = p.a_q_norm[128 + t];  cst[3 * 256 + 128 + t] = p.a_k_norm[128 + t];
    cst[1024 + t] = p.c_subln[t];
    if (t < 8) cst[1152 + t] = p.b_f_bias[t];
    if (t == 0) {
      float gq = 0.f, gk = 0.f;
      for (int i = 0; i < 128; ++i) { gq = fmaxf(gq, fabsf(p.b_q_norm[i])); gk = fmaxf(gk, fabsf(p.b_k_norm[i])); }
      cst[1160] = 2.0f * 128.0f * gq * gk * 1.02f * (0.08838834764831845f * kLog2e);
    }
  }
  if (blockIdx.x == 0 && t < 64) {
    float a = p.c_lq1[t] * p.c_lk1[t], b = p.c_lq2[t] * p.c_lk2[t];
    a = wave_sum(a); b = wave_sum(b);
    if (t == 0) {
      float* lam = (float*)(p.ws + OFF_LAM);
      const float li = 0.8f - 0.6f * expf(-0.3f * 2.0f);
      lam[0] = expf(a) - expf(b) + li;
      lam[1] = 1.0f - li;
    }
  }
}

constexpr int HTB = 16384;
DI int lds_byte(int r, int c) { const int st = (r >> 4) * 2 + (c >> 5), rr = r & 15, cc = c & 31, ob = rr * 64 + cc * 2; return st * 1024 + (ob ^ (((ob >> 9) & 1) << 5)); }
DI void stage_rc(int b, int& R, int& C) { const int st = b / 1024, sb = b % 1024, swz = sb ^ (((sb >> 9) & 1) << 5); R = (st >> 1) * 16 + swz / 64; C = (st & 1) * 32 + (swz % 64) / 2; }

DI void gemm_unit(const bf16* __restrict__ A, const bf16* __restrict__ Bt, LAS unsigned char* lds, f32x4 (&acc)[2][2][4][2], const int tid) {
  constexpr int K = 1024, nt = 16;
  const int wid = __builtin_amdgcn_readfirstlane(tid >> 6), lane = tid & 63, wr = wid >> 2, wc = wid & 3, fr = lane & 15, fq = lane >> 4;
  unsigned voff[2];
#pragma unroll
  for (int i = 0; i < 2; ++i) { int R, C; stage_rc(tid * 16 + i * 8192, R, C); voff[i] = (unsigned)(R * K + C) * 2u; }
  const size_t kstep = 128, hstep = (size_t)128 * K * 2;
  const unsigned ldsw = (unsigned)wid * 1024u;
  const int aoff = lds_byte(wr * 64 + fr, fq * 8), boff = lds_byte(wc * 32 + fr, fq * 8);
  const char* cA = (const char*)A; const char* cB = (const char*)Bt;
#define G_SA(b, h) (((b) * 2 + (h)) * HTB)
#define G_SB(b, h) ((4 + (b) * 2 + (h)) * HTB)
#define G_STAGE(bufoff, gbase) do { _Pragma("unroll") for (int _i = 0; _i < 2; ++_i) \
    __builtin_amdgcn_global_load_lds((const unsigned*)((const char*)(gbase) + voff[_i]), (LAS unsigned*)(lds + (bufoff) + ldsw + _i * 8192), 16, 0, 0); } while (0)
#define G_LDA(dst, b, h) do { _Pragma("unroll") for (int m = 0; m < 4; ++m) _Pragma("unroll") for (int k = 0; k < 2; ++k) dst[m][k] = *(const LAS bf16x8*)(lds + G_SA(b, h) + aoff + m * 2048 + k * 1024); } while (0)
#define G_LDB(dst, b, h) do { _Pragma("unroll") for (int n = 0; n < 2; ++n) _Pragma("unroll") for (int k = 0; k < 2; ++k) dst[n][k] = *(const LAS bf16x8*)(lds + G_SB(b, h) + boff + n * 2048 + k * 1024); } while (0)
#define G_MMA(ai, bj, At, Bx) do { __builtin_amdgcn_s_setprio(1); _Pragma("unroll") for (int m = 0; m < 4; ++m) _Pragma("unroll") for (int n = 0; n < 2; ++n) _Pragma("unroll") for (int k = 0; k < 2; ++k) \
    acc[ai][bj][m][n] = __builtin_amdgcn_mfma_f32_16x16x32_bf16(Bx[n][k], At[m][k], acc[ai][bj][m][n], 0, 0, 0); __builtin_amdgcn_s_setprio(0); } while (0)
#define G_WAIT_V(n) asm volatile("s_waitcnt vmcnt(" #n ")" ::: "memory")
#define G_WAIT_L(n) asm volatile("s_waitcnt lgkmcnt(" #n ")" ::: "memory")
#define G_BAR __builtin_amdgcn_s_barrier()
#define G_SCHED __builtin_amdgcn_sched_barrier(0)
#pragma unroll
  for (int a = 0; a < 2; ++a)
#pragma unroll
    for (int b = 0; b < 2; ++b)
#pragma unroll
      for (int m = 0; m < 4; ++m)
#pragma unroll
        for (int n = 0; n < 2; ++n) acc[a][b][m][n] = (f32x4){0.f, 0.f, 0.f, 0.f};
  bf16x8 At[4][2], B0[2][2], B1[2][2];
  G_STAGE(G_SB(0, 0), cB); G_STAGE(G_SA(0, 0), cA); G_STAGE(G_SB(0, 1), cB + hstep); G_STAGE(G_SA(0, 1), cA + hstep);
  if (wr == 1) G_BAR;
  G_WAIT_V(4); G_BAR;
  G_STAGE(G_SB(1, 0), cB + kstep); G_STAGE(G_SA(1, 0), cA + kstep); G_STAGE(G_SB(1, 1), cB + hstep + kstep);
  G_WAIT_V(6); G_BAR;
#pragma unroll 1
  for (int t = 0; t < nt - 2; t += 2) {
    const char* a1 = cA + (size_t)(t + 1) * kstep;
    const char* a2 = cA + (size_t)(t + 2) * kstep; const char* b2 = cB + (size_t)(t + 2) * kstep;
    const char* a3 = a2 + kstep; const char* b3 = b2 + kstep;
    G_LDB(B0, 0, 0); G_SCHED; G_LDA(At, 0, 0); G_STAGE(G_SA(1, 1), a1 + hstep);
    G_WAIT_L(8); G_BAR; G_WAIT_L(0); G_MMA(0, 0, At, B0); G_BAR; G_SCHED;
    G_LDB(B1, 0, 1); G_STAGE(G_SB(0, 0), b2);
    G_BAR; G_WAIT_L(0); G_MMA(0, 1, At, B1); G_BAR;
    G_LDA(At, 0, 1); G_STAGE(G_SA(0, 0), a2);
    G_BAR; G_WAIT_L(0); G_MMA(1, 0, At, B0); G_BAR; G_SCHED;
    G_STAGE(G_SB(0, 1), b2 + hstep);
    G_WAIT_V(6); G_BAR; G_MMA(1, 1, At, B1); G_BAR;
    G_LDB(B0, 1, 0); G_SCHED; G_LDA(At, 1, 0); G_STAGE(G_SA(0, 1), a2 + hstep);
    G_WAIT_L(8); G_BAR; G_WAIT_L(0); G_MMA(0, 0, At, B0); G_BAR; G_SCHED;
    G_LDB(B1, 1, 1); G_STAGE(G_SB(1, 0), b3);
    G_BAR; G_WAIT_L(0); G_MMA(0, 1, At, B1); G_BAR;
    G_LDA(At, 1, 1); G_STAGE(G_SA(1, 0), a3);
    G_BAR; G_WAIT_L(0); G_MMA(1, 0, At, B0); G_BAR; G_SCHED;
    G_STAGE(G_SB(1, 1), b3 + hstep);
    G_WAIT_V(6); G_BAR; G_MMA(1, 1, At, B1); G_BAR;
  }
  { G_LDB(B0, 0, 0); G_LDA(At, 0, 0); G_STAGE(G_SA(1, 1), cA + hstep + (size_t)(nt - 1) * kstep);
    G_BAR; G_WAIT_L(0); G_MMA(0, 0, At, B0); G_BAR;
    G_LDB(B1, 0, 1); G_BAR; G_WAIT_L(0); G_MMA(0, 1, At, B1); G_BAR;
    G_LDA(At, 0, 1); G_WAIT_V(4); G_BAR; G_WAIT_L(0); G_MMA(1, 0, At, B0); G_MMA(1, 1, At, B1); G_BAR; }
  { G_LDB(B0, 1, 0); G_LDA(At, 1, 0); G_WAIT_V(2); G_BAR; G_WAIT_L(0); G_MMA(0, 0, At, B0); G_BAR;
    G_LDB(B1, 1, 1); G_WAIT_V(0); G_BAR; G_WAIT_L(0); G_MMA(0, 1, At, B1); G_BAR;
    G_LDA(At, 1, 1); G_BAR; G_WAIT_L(0); G_MMA(1, 0, At, B0); G_MMA(1, 1, At, B1); G_BAR; }
  if (wr == 0) G_BAR;
#undef G_SA
#undef G_SB
#undef G_STAGE
#undef G_LDA
#undef G_LDB
#undef G_MMA
#undef G_WAIT_V
#undef G_WAIT_L
#undef G_BAR
#undef G_SCHED
}

DI bool unit_next(int i, int nM, int nN, int& pm, int& pn) {
  const int nwg = nM * nN;
  const long Lg = (long)i * gridDim.x + blockIdx.x;
  if (Lg >= nwg) return false;
  int wgid = (int)Lg;
  { const int q = nwg / 8, r = nwg % 8, xcd = wgid % 8, off = wgid / 8; wgid = (xcd < r ? xcd * (q + 1) : r * (q + 1) + (xcd - r) * q) + off; }
  const int nig = 8 * nN, gid = wgid / nig, fm = gid * 8, gsz = (nM - fm) < 8 ? (nM - fm) : 8;
  pm = fm + ((wgid % nig) % gsz); pn = (wgid % nig) / gsz;
  return true;
}

DI void sub_to_lds(float* Cs, const f32x4 (&a)[4][2], const int t) {
  const int lane = t & 63, w = t >> 6, wr = w >> 2, wc = w & 3, fr = lane & 15, fq = lane >> 4;
#pragma unroll
  for (int m = 0; m < 4; ++m)
#pragma unroll
    for (int n = 0; n < 2; ++n)
      *(f32x4*)(Cs + (wr * 64 + m * 16 + fr) * 132 + wc * 32 + n * 16 + fq * 4) = a[m][n];
}

DI void sub_to_lds_T(float* Cs, const f32x4 (&a)[4][2], const int t) {
  const int lane = t & 63, w = t >> 6, wr = w >> 2, wc = w & 3, fr = lane & 15, fq = lane >> 4;
#pragma unroll
  for (int m = 0; m < 4; ++m)
#pragma unroll
    for (int n = 0; n < 2; ++n)
#pragma unroll
      for (int j = 0; j < 4; ++j)
        Cs[(wc * 32 + n * 16 + fq * 4 + j) * 132 + wr * 64 + m * 16 + fr] = a[m][n][j];
}

DI float red16(float v) {
  v += __int_as_float(__builtin_amdgcn_update_dpp(0, __float_as_int(v), 0xB1, 0xF, 0xF, true));
  v += __int_as_float(__builtin_amdgcn_update_dpp(0, __float_as_int(v), 0x4E, 0xF, 0xF, true));
  v += __int_as_float(__builtin_amdgcn_update_dpp(0, __float_as_int(v), 0x141, 0xF, 0xF, true));
  v += __int_as_float(__builtin_amdgcn_update_dpp(0, __float_as_int(v), 0x140, 0xF, 0xF, true));
  return v;
}

DI void epi_qk(const float* Cs, const float* rs, const int kind, bf16* dst, const float4 gn, const float4 gp,
               float4 c4, float4 s4, const float4 dc4, const float4 ds4, float* kc, const bool want_kc, const int rg, const int c0) {
  const int dsub = (kind == 2) ? 64 : 128, half = dsub >> 1;
  const int cp = c0 ^ half;
  const float inv_d = 1.0f / (float)dsub;
  const float sg = (c0 & half) ? 1.f : -1.f;
  float cs0 = 0.f, cs1 = 0.f, cs2 = 0.f, cs3 = 0.f;
  float ssv[8];
#pragma unroll
  for (int pass = 0; pass < 8; ++pass) {
    const int row = pass * 16 + rg;
    const float4 v = *(const float4*)(Cs + row * 132 + c0);
    ssv[pass] = v.x * v.x + v.y * v.y + v.z * v.z + v.w * v.w;
  }
#pragma unroll
  for (int pass = 0; pass < 8; ++pass) ssv[pass] = red16(ssv[pass]);
  if (dsub == 128) {
#pragma unroll
    for (int pass = 0; pass < 8; ++pass) ssv[pass] += __shfl_xor(ssv[pass], 16);
  }
#pragma unroll
  for (int pass = 0; pass < 8; ++pass) {
    const int row = pass * 16 + rg;
    const float rr = rs[row];
    const float4 v = *(const float4*)(Cs + row * 132 + c0);
    const float rn = rsqrtf(ssv[pass] * rr * rr * inv_d + kEps) * rr;
    float o0 = v.x * rn * gn.x, o1 = v.y * rn * gn.y, o2 = v.z * rn * gn.z, o3 = v.w * rn * gn.w;
    if (kind != 1) {
      const float4 pv = *(const float4*)(Cs + row * 132 + cp);
      const float pr = rn * sg;
      o0 = o0 * c4.x + pv.x * pr * gp.x * s4.x;
      o1 = o1 * c4.y + pv.y * pr * gp.y * s4.y;
      o2 = o2 * c4.z + pv.z * pr * gp.z * s4.z;
      o3 = o3 * c4.w + pv.w * pr * gp.w * s4.w;
      float tc;
      tc = c4.x * dc4.x - s4.x * ds4.x; s4.x = s4.x * dc4.x + c4.x * ds4.x; c4.x = tc;
      tc = c4.y * dc4.y - s4.y * ds4.y; s4.y = s4.y * dc4.y + c4.y * ds4.y; c4.y = tc;
      tc = c4.z * dc4.z - s4.z * ds4.z; s4.z = s4.z * dc4.z + c4.z * ds4.z; c4.z = tc;
      tc = c4.w * dc4.w - s4.w * ds4.w; s4.w = s4.w * dc4.w + c4.w * ds4.w; c4.w = tc;
    }
    *(uint2*)((unsigned char*)dst + (unsigned)((row * 128 + c0) * 2)) = make_uint2(pk2(o0, o1), pk2(o2, o3));
    cs0 += o0; cs1 += o1; cs2 += o2; cs3 += o3;
  }
  if (want_kc) *(float4*)(kc + rg * 128 + c0) = make_float4(cs0, cs1, cs2, cs3);
}

DI void phase_inproj(const Params& p, int layer, unsigned char* smem) {
  const int kind = layer % 3, jj = layer / 3;
  const bf16* XB = (const bf16*)(p.ws + OFF_XB);
  const bf16* WT = (const bf16*)(p.ws + OFF_WTIN) + (size_t)layer * kNPAD * 1024;
  const float* rowsq = (const float*)(p.ws + OFF_ROWSQ);
  float* CsA = (float*)smem;
  float* CsB = (float*)(smem + 67584);
  float* kcA = (float*)(smem + 135168);
  float* kcB = (float*)(smem + 143360);
  float* rs_all = (float*)(smem + 151552);
  float rs_next = 0.f;
  {
    int pm, pn;
    if (unit_next(0, 128, 16, pm, pn)) {
      const int t0 = opaque_tid();
      float s = 0.f;
#pragma unroll
      for (int j = 0; j < 8; ++j) s += *(const float*)((const unsigned char*)rowsq + (unsigned)((j * kM + pm * 256 + (t0 & 255)) * 4));
      rs_next = rsqrtf(s * (1.0f / 1024.0f) + kEps);
    }
  }
#pragma unroll 1
  for (int ui = 0;; ++ui) {
    int pm, pn;
    if (!unit_next(ui, 128, 16, pm, pn)) break;
    const int t = opaque_tid();
    float my_rs = rs_next;
    f32x4 acc[2][2][4][2];
    gemm_unit(XB + (size_t)pm * 256 * 1024, WT + (size_t)pn * 256 * 1024, (LAS unsigned char*)smem, acc, t);
    const int type = pn >> 2;
    { const int t0 = opaque_tid(); if (t0 < 256) rs_all[t0] = my_rs; }
    if (type == 3) {
      __syncthreads();
      const int tz = opaque_tid();
      const int lane = tz & 63, w = tz >> 6, wr = w >> 2, wc = w & 3, fr = lane & 15, fq = lane >> 4;
      unsigned char* gbase = p.ws + OFF_G + ((size_t)pm * 256 * 1024 + (size_t)((pn * 2) & 7) * 128) * 2;
#pragma unroll
      for (int ai = 0; ai < 2; ++ai)
#pragma unroll
        for (int m = 0; m < 4; ++m) {
          const int rowl = ai * 128 + wr * 64 + m * 16 + fr;
          const float rr = rs_all[rowl];
#pragma unroll
          for (int bj = 0; bj < 2; ++bj)
#pragma unroll
            for (int n = 0; n < 2; ++n) {
              const f32x4 a = acc[ai][bj][m][n] * rr;
              const float g0 = a[0] * __builtin_amdgcn_rcpf(1.f + __builtin_amdgcn_exp2f(-kLog2e * a[0]));
              const float g1 = a[1] * __builtin_amdgcn_rcpf(1.f + __builtin_amdgcn_exp2f(-kLog2e * a[1]));
              const float g2 = a[2] * __builtin_amdgcn_rcpf(1.f + __builtin_amdgcn_exp2f(-kLog2e * a[2]));
              const float g3 = a[3] * __builtin_amdgcn_rcpf(1.f + __builtin_amdgcn_exp2f(-kLog2e * a[3]));
              *(uint2*)(gbase + (unsigned)((rowl * 1024 + bj * 128 + wc * 32 + n * 16 + fq * 4) * 2)) = make_uint2(pk2(g0, g1), pk2(g2, g3));
            }
        }
    } else
#pragma unroll
    for (int ai = 0; ai < 2; ++ai) {
      const int te = opaque_tid();
      const int rg = te >> 5, L = te & 31, c0 = 4 * L;
      const int m0 = pm * 256 + ai * 128;
      const float* rs = rs_all + ai * 128;
      const int b = m0 >> 11, s0 = m0 & 2047;
      float4 gn = make_float4(0.f, 0.f, 0.f, 0.f), gp = gn, c4 = gn, s4 = gn, dc4 = gn, ds4 = gn;
      if (type < 2) {
        const int dsub_ = (kind == 2) ? 64 : 128, half_ = dsub_ >> 1;
        const float* gain = (const float*)(p.ws + OFF_CONST) + layer * 256 + type * 128;
        gn = *(const float4*)(gain + (c0 & (dsub_ - 1)));
        gp = *(const float4*)(gain + ((c0 ^ half_) & (dsub_ - 1)));
        if (kind != 1) {
          const float* cosT = (const float*)(p.ws + ((kind == 2) ? OFF_COSD : OFF_COSH));
          const float* sinT = (const float*)(p.ws + ((kind == 2) ? OFF_SIND : OFF_SINH));
          const int fi_ = c0 & (half_ - 1);
          c4 = *(const float4*)(cosT + (size_t)(s0 + rg) * half_ + fi_);
          s4 = *(const float4*)(sinT + (size_t)(s0 + rg) * half_ + fi_);
          dc4 = *(const float4*)(cosT + (size_t)16 * half_ + fi_);
          ds4 = *(const float4*)(sinT + (size_t)16 * half_ + fi_);
        }
      }
      __syncthreads();
      if (type == 2) { sub_to_lds_T(CsA, acc[ai][0], te); sub_to_lds_T(CsB, acc[ai][1], te); }
      else { sub_to_lds(CsA, acc[ai][0], te); sub_to_lds(CsB, acc[ai][1], te); }
      __syncthreads();
      const int hd0 = (pn * 2) & 7;
      if (type < 2) {
        const bool want_kc = (kind == 0 && type == 1);
        bf16* base = (bf16*)(p.ws + ((type == 0) ? OFF_Q : OFF_K));
        epi_qk(CsA, rs, kind, base + ((size_t)(b * 8 + hd0) * kS + s0) * 128, gn, gp, c4, s4, dc4, ds4, kcA, want_kc, rg, c0);
        epi_qk(CsB, rs, kind, base + ((size_t)(b * 8 + hd0 + 1) * kS + s0) * 128, gn, gp, c4, s4, dc4, ds4, kcB, want_kc, rg, c0);
        if (want_kc) {
          __syncthreads();
          if (te < 256) {
            const float* kc = (te < 128) ? kcA : kcB;
            const int col = te & 127;
            float s = 0.f;
#pragma unroll
            for (int j = 0; j < 16; ++j) s += kc[j * 128 + col];
            float* kpart = (float*)(p.ws + OFF_KPART);
            kpart[((size_t)(b * 8 + hd0 + (te >> 7)) * 16 + (s0 >> 7)) * 128 + col] = s;
          }
        }
      } else if (type == 2) {
        const int tok = 4 * L;
        const float4 r4 = *(const float4*)(rs + tok);
#pragma unroll
        for (int bj = 0; bj < 2; ++bj) {
          const float* Cs = bj ? CsB : CsA;
          unsigned char* dst = p.ws + OFF_VT + ((size_t)(b * 8 + hd0 + bj) * 128 * kS + s0) * 2;
#pragma unroll
          for (int pass = 0; pass < 8; ++pass) {
            const int dv = pass * 16 + rg;
            const float4 a = *(const float4*)(Cs + dv * 132 + tok);
            *(uint2*)(dst + (unsigned)((dv * kS + tok) * 2)) = make_uint2(pk2(a.x * r4.x, a.y * r4.y), pk2(a.z * r4.z, a.w * r4.w));
          }
        }
      } else {
#pragma unroll
        for (int bj = 0; bj < 2; ++bj) {
          const float* Cs = bj ? CsB : CsA;
          bf16* dst = (bf16*)(p.ws + OFF_G) + (size_t)m0 * 1024 + (hd0 + bj) * 128;
#pragma unroll
          for (int pass = 0; pass < 8; ++pass) {
            const int row = pass * 16 + rg;
            const float rr = rs[row];
            float4 v = *(const float4*)(Cs + row * 132 + c0);
            v.x *= rr; v.y *= rr; v.z *= rr; v.w *= rr;
            const float g0 = v.x * __builtin_amdgcn_rcpf(1.f + __builtin_amdgcn_exp2f(-kLog2e * v.x));
            const float g1 = v.y * __builtin_amdgcn_rcpf(1.f + __builtin_amdgcn_exp2f(-kLog2e * v.y));
            const float g2 = v.z * __builtin_amdgcn_rcpf(1.f + __builtin_amdgcn_exp2f(-kLog2e * v.z));
            const float g3 = v.w * __builtin_amdgcn_rcpf(1.f + __builtin_amdgcn_exp2f(-kLog2e * v.w));
            *(uint2*)(dst + (size_t)row * 1024 + c0) = make_uint2(pk2(g0, g1), pk2(g2, g3));
          }
        }
      }
    }
    {
      int pm2, pn2;
      if (unit_next(ui + 1, 128, 16, pm2, pn2)) {
        const int tn = opaque_tid();
        float s = 0.f;
#pragma unroll
        for (int j = 0; j < 8; ++j) s += *(const float*)((const unsigned char*)rowsq + (unsigned)((j * kM + pm2 * 256 + (tn & 255)) * 4));
        rs_next = rsqrtf(s * (1.0f / 1024.0f) + kEps);
      }
    }
    __syncthreads();
  }
  if (kind == 1) {
    const int t = opaque_tid();
    const int lane = t & 63, w = t >> 6, fr = lane & 15, fq = lane >> 4;
    float* logf = (float*)(p.ws + OFF_LOGF);
    for (int task = blockIdx.x * 8 + w; task < kM / 16; task += gridDim.x * 8) {
      const int row0 = task * 16;
      const bf16* ap = XB + (size_t)(row0 + fr) * 1024 + fq * 8;
      const bf16* bp = WT + (size_t)(4096 + fr) * 1024 + fq * 8;
      f32x4 c = (f32x4){0.f, 0.f, 0.f, 0.f};
#pragma unroll 8
      for (int ks = 0; ks < 32; ++ks) {
        const bf16x8 a = *(const bf16x8*)(ap + ks * 32);
        const bf16x8 bb = *(const bf16x8*)(bp + ks * 32);
        c = __builtin_amdgcn_mfma_f32_16x16x32_bf16(a, bb, c, 0, 0, 0);
      }
      if (fr < 8) {
        const float bias = ((const float*)(p.ws + OFF_CONST))[1152 + fr];
#pragma unroll
        for (int j = 0; j < 4; ++j) {
          const int m = row0 + fq * 4 + j;
          float s = 0.f;
#pragma unroll
          for (int q = 0; q < 8; ++q) s += rowsq[(size_t)q * kM + m];
          const float rr = rsqrtf(s * (1.0f / 1024.0f) + kEps);
          const float f = c[j] * rr + bias;
          const float lf = fminf(f, 0.f) - log1pf(expf(-fabsf(f)));
          logf[(size_t)((m >> 11) * 8 + fr) * kS + (m & 2047)] = lf;
        }
      }
    }
  }
}

DI void phase_outproj(const Params& p, int layer, unsigned char* smem) {
  const bf16* Y = (const bf16*)(p.ws + OFF_Y);
  const bf16* WT = (const bf16*)(p.ws + OFF_WTOUT) + (size_t)layer * 1024 * 1024;
  const float* xold = (layer == 0) ? p.x : p.out;
  float* CsA = (float*)smem;
  float* CsB = (float*)(smem + 67584);
#pragma unroll 1
  for (int ui = 0;; ++ui) {
    int pm, pn;
    if (!unit_next(ui, 128, 4, pm, pn)) break;
    const int t = opaque_tid();
    f32x4 acc[2][2][4][2];
    gemm_unit(Y + (size_t)pm * 256 * 1024, WT + (size_t)pn * 256 * 1024, (LAS unsigned char*)smem, acc, t);
#pragma unroll
    for (int ai = 0; ai < 2; ++ai) {
      const int te = opaque_tid();
      const int rg = te >> 5, L = te & 31, c0 = 4 * L;
      const int m0 = pm * 256 + ai * 128;
      const unsigned char* xbase = (const unsigned char*)(xold + (size_t)m0 * 1024 + pn * 256);
      unsigned char* obase = (unsigned char*)(p.out + (size_t)m0 * 1024 + pn * 256);
      unsigned char* bbase = p.ws + OFF_XB + ((size_t)m0 * 1024 + pn * 256) * 2;
      float* rsq = (float*)(p.ws + OFF_ROWSQ) + m0;
      f32x4 xpre[8];
#pragma unroll
      for (int pass = 0; pass < 8; ++pass) xpre[pass] = *(const f32x4*)(xbase + (unsigned)(((pass * 16 + rg) * 1024 + c0) * 4));
      __syncthreads();
      sub_to_lds(CsA, acc[ai][0], te);
      sub_to_lds(CsB, acc[ai][1], te);
      __syncthreads();
#pragma unroll
      for (int bj = 0; bj < 2; ++bj) {
        const float* Cs = bj ? CsB : CsA;
        const int nt = pn * 2 + bj;
        f32x4 xnext[8];
        if (bj == 0) {
#pragma unroll
          for (int pass = 0; pass < 8; ++pass) xnext[pass] = *(const f32x4*)(xbase + (unsigned)(((pass * 16 + rg) * 1024 + 128 + c0) * 4));
        }
        float ssv[8];
#pragma unroll
        for (int pass = 0; pass < 8; ++pass) {
          const int row = pass * 16 + rg;
          const unsigned off = (unsigned)(row * 1024 + bj * 128 + c0);
          const f32x4 c = *(const f32x4*)(Cs + row * 132 + c0);
          const f32x4 xn = xpre[pass] + c;
          *(f32x4*)(obase + off * 4u) = xn;
          if (layer < 3) {
            *(uint2*)(bbase + off * 2u) = make_uint2(pk2(xn[0], xn[1]), pk2(xn[2], xn[3]));
            ssv[pass] = xn[0] * xn[0] + xn[1] * xn[1] + xn[2] * xn[2] + xn[3] * xn[3];
          }
        }
        if (layer < 3) {
#pragma unroll
          for (int pass = 0; pass < 8; ++pass) ssv[pass] = red16(ssv[pass]);
#pragma unroll
          for (int pass = 0; pass < 8; ++pass) {
            const float tot = ssv[pass] + __shfl_xor(ssv[pass], 16);
            if (L == 0) rsq[(size_t)nt * kM + pass * 16 + rg] = tot;
          }
        }
        if (bj == 0) {
#pragma unroll
          for (int pass = 0; pass < 8; ++pass) xpre[pass] = xnext[pass];
        }
      }
    }
    __syncthreads();
  }
}

template <int MODE>
DI void attn_phase(const Params& p, unsigned char* smem, const int layer) {
  constexpr int NQ = (MODE == 2) ? 128 : 256;
  constexpr int NQB = kS / NQ;
  constexpr int KSN = (MODE == 2) ? 4 : 8;
  const bf16* Qg = (const bf16*)(p.ws + OFF_Q);
  const bf16* Kg = (const bf16*)(p.ws + OFF_K);
  const bf16* VTg = (const bf16*)(p.ws + OFF_VT);
  const bf16* Gg = (const bf16*)(p.ws + OFF_G);
  bf16* Yg = (bf16*)(p.ws + OFF_Y);
  constexpr int KBUF = 17408, VBUF = 18432, VOFF = 2 * KBUF;
  float* cs = (float*)(smem + 71680);
  float* kmean = cs;
  int* sel = (int*)(smem + 79872);
  float* wtot = (float*)(smem + 80896);
  const float sc = ((MODE == 2) ? 0.125f : 0.08838834764831845f) * kLog2e;
  const float isc = 1.0f / sc;
  const int total = 128 * NQB, G = gridDim.x;

  unsigned* qctr = (unsigned*)(p.ws + OFF_BAR) + 3584 + layer * 64;
  int* qslot = (int*)(smem + SMEM_BYTES - 16);
  (void)G;
  if (threadIdx.x == 0) qslot[0] = (int)atomicAdd(qctr, 1u);
  __syncthreads();
#pragma unroll 1
  for (;;) {
    const int wi = qslot[0];
    if (wi >= total) break;
    int nxt_w = 0;
    if (threadIdx.x == 0) nxt_w = (int)atomicAdd(qctr, 1u);
    const int t = opaque_tid();
    const int lane = t & 63, w = t >> 6, r = lane & 31, h = lane >> 5;
    const int map = (MODE == 2) ? (w >> 2) : 0;
    const int qsub = (MODE == 2) ? (w & 3) : w;
    const int pir = (r & ~12) | ((r & 4) << 1) | ((r & 8) >> 1);
    const int koff_b = (MODE == 2) ? map * 128 : 0;
    const int qb = NQB - 1 - (wi >> 7), bh = wi & 127, b = bh >> 3, hd = bh & 7;
    const int q0 = qb * NQ;
    const int q0w = q0 + 32 * qsub;
    const int qrow = q0w + r;

    bf16x8 bq[KSN];
    {
      const bf16* qp = Qg + ((size_t)bh * kS + qrow) * 128 + ((MODE == 2) ? map * 64 : 0) + 8 * h;
#pragma unroll
      for (int ks = 0; ks < KSN; ++ks) bq[ks] = *(const bf16x8*)(qp + 16 * ks);
    }

    float cq2 = 0.f;
    int j0 = 0;
    float fox_lim = 0.f;
    int mymask = 0;
    int own = 0;
    if (MODE == 1) {
      const int nel = q0 + NQ;
      const float* lf = (const float*)(p.ws + OFF_LOGF) + (size_t)bh * kS;
      float v0 = 0.f, v1 = 0.f, v2 = 0.f, v3 = 0.f;
      const int base = t * 4;
      if (base < nel) { const float4 a = *(const float4*)(lf + base); v0 = a.x; v1 = a.y; v2 = a.z; v3 = a.w; }
      v1 += v0; v2 += v1; v3 += v2;
      const float tot = v3;
      float inc = tot;
#pragma unroll
      for (int o = 1; o < 64; o <<= 1) { const float y = __shfl_up(inc, o); if (lane >= o) inc += y; }
      if (lane == 63) wtot[w] = inc;
      __syncthreads();
      float off = inc - tot;
#pragma unroll
      for (int ww = 0; ww < 7; ++ww) if (ww < w) off += wtot[ww];
      if (base < nel) *(float4*)(cs + base) = make_float4((off + v0) * kLog2e, (off + v1) * kLog2e, (off + v2) * kLog2e, (off + v3) * kLog2e);
      __syncthreads();
      cq2 = cs[qrow];
      if (t < 64) {
        const float twoB = ((const float*)(p.ws + OFF_CONST))[1160];
        const int tl_ = t & 31;
        const int last = (q0 + NQ - 1) >> 6;
        const bool sk = (tl_ <= last) && (twoB + cs[q0] - cs[64 * tl_ + 63] < -152.0f);
        const unsigned long long bal = __builtin_amdgcn_ballot_w64(sk);
        const unsigned lowm = (unsigned)(bal & 0xffffffffull);
        if (t == 0) sel[0] = (lowm == 0xffffffffu) ? 0 : __builtin_ctz(~lowm);
      }
      __syncthreads();
      j0 = sel[0];
      fox_lim = ((const float*)(p.ws + OFF_CONST))[1160] + cs[q0w] + 152.0f;
    }
    if (MODE == 0) {
      own = qb;
      if (own > 3) {
        const float* kpart = (const float*)(p.ws + OFF_KPART) + (size_t)bh * 16 * 128;
        {
          const int d = t & 127;
#pragma unroll
          for (int i = 0; i < 2; ++i) {
            const int nb = (t >> 7) + 4 * i;
            if (nb < own) kmean[nb * 128 + d] = (kpart[(2 * nb) * 128 + d] + kpart[(2 * nb + 1) * 128 + d]) * (1.0f / 256.0f);
          }
        }
        __syncthreads();
        const int qi = t >> 1, hf = t & 1;
        const bf16* qp = Qg + ((size_t)bh * kS + q0 + qi) * 128 + hf * 64;
        float ga[7];
#pragma unroll
        for (int nb = 0; nb < 7; ++nb) ga[nb] = 0.f;
#pragma unroll 2
        for (int c = 0; c < 8; ++c) {
          const uint4 qv = *(const uint4*)(qp + c * 8);
          float qf[8];
          qf[0] = bf_lo(qv.x); qf[1] = bf_hi(qv.x); qf[2] = bf_lo(qv.y); qf[3] = bf_hi(qv.y);
          qf[4] = bf_lo(qv.z); qf[5] = bf_hi(qv.z); qf[6] = bf_lo(qv.w); qf[7] = bf_hi(qv.w);
#pragma unroll
          for (int nb = 0; nb < 7; ++nb) {
            if (nb < own) {
              const float* km = kmean + nb * 128 + hf * 64 + c * 8;
#pragma unroll
              for (int e = 0; e < 8; ++e) ga[nb] += qf[e] * km[e];
            }
          }
        }
        int mask = 0;
#pragma unroll
        for (int nb = 0; nb < 7; ++nb) ga[nb] += __shfl_xor(ga[nb], 1);
#pragma unroll
        for (int pick = 0; pick < 3; ++pick) {
          float best = -3.0e38f; int bi = 0;
#pragma unroll
          for (int nb = 0; nb < 7; ++nb) {
            const bool ok = (nb < own) && !((mask >> nb) & 1) && (ga[nb] > best);
            if (ok) { best = ga[nb]; bi = nb; }
          }
          mask |= (1 << bi);
        }
        if (hf == 0) sel[qi] = mask;
      } else {
        if (t < 256) sel[t] = (1 << own) - 1;
      }
      __syncthreads();
      mymask = sel[32 * qsub + r];
    }

    const int tend = (q0 + NQ - 1) >> 6;
    const unsigned char* kg = (const unsigned char*)(Kg + (size_t)bh * kS * 128);
    const unsigned char* vg = (const unsigned char*)(VTg + (size_t)bh * 128 * kS);
    u32x4 kreg[2], vreg[2];
    const int k_lds = (t >> 4) * 272 + (t & 15) * 16;
    const int v_lds = VOFF + (t >> 3) * 144 + (t & 7) * 16;
    const unsigned k_go = (unsigned)t * 16u;
    const unsigned v_go = (unsigned)(t >> 3) * 4096u + (unsigned)(t & 7) * 16u;
#pragma unroll
    for (int i = 0; i < 2; ++i) {
      kreg[i] = *(const u32x4*)(kg + (size_t)j0 * 16384 + (k_go + i * 8192u));
      vreg[i] = *(const u32x4*)(vg + (size_t)j0 * 128 + (v_go + i * 262144u));
    }
#pragma unroll
    for (int i = 0; i < 2; ++i) {
      *(u32x4*)(smem + (j0 & 1) * KBUF + k_lds + i * 32 * 272) = kreg[i];
      *(u32x4*)(smem + (j0 & 1) * VBUF + v_lds + i * 64 * 144) = vreg[i];
    }
    __syncthreads();

    f32x16 o[4];
#pragma unroll
    for (int d = 0; d < 4; ++d)
#pragma unroll
      for (int i = 0; i < 16; ++i) o[d][i] = 0.f;
    float m_run = kNeg, l_run = 0.f;

#pragma unroll 1
    for (int tile = j0; tile <= tend; ++tile) {
      const int cur = tile & 1;
      if (tile < tend) {
#pragma unroll
        for (int i = 0; i < 2; ++i) {
          kreg[i] = *(const u32x4*)(kg + (size_t)(tile + 1) * 16384 + (k_go + i * 8192u));
          vreg[i] = *(const u32x4*)(vg + (size_t)(tile + 1) * 128 + (v_go + i * 262144u));
        }
      }
      const int kb = tile * 64;
      const bool act = (kb <= q0w + 31) && !(MODE == 1 && cs[kb + 63] > fox_lim);
      const unsigned char* Ks = smem + cur * KBUF;
      const unsigned char* Vs = smem + VOFF + cur * VBUF;
      f32x16 s0, s1;
      if (act) {
        if (MODE == 1) {
#pragma unroll
          for (int g = 0; g < 2; ++g) {
            const float4 ca = *(const float4*)(cs + kb + 8 * h + 16 * g);
            const float4 cb = *(const float4*)(cs + kb + 8 * h + 16 * g + 4);
            s0[8 * g + 0] = (cq2 - ca.x) * isc; s0[8 * g + 1] = (cq2 - ca.y) * isc; s0[8 * g + 2] = (cq2 - ca.z) * isc; s0[8 * g + 3] = (cq2 - ca.w) * isc;
            s0[8 * g + 4] = (cq2 - cb.x) * isc; s0[8 * g + 5] = (cq2 - cb.y) * isc; s0[8 * g + 6] = (cq2 - cb.z) * isc; s0[8 * g + 7] = (cq2 - cb.w) * isc;
            const float4 cc = *(const float4*)(cs + kb + 32 + 8 * h + 16 * g);
            const float4 cd = *(const float4*)(cs + kb + 32 + 8 * h + 16 * g + 4);
            s1[8 * g + 0] = (cq2 - cc.x) * isc; s1[8 * g + 1] = (cq2 - cc.y) * isc; s1[8 * g + 2] = (cq2 - cc.z) * isc; s1[8 * g + 3] = (cq2 - cc.w) * isc;
            s1[8 * g + 4] = (cq2 - cd.x) * isc; s1[8 * g + 5] = (cq2 - cd.y) * isc; s1[8 * g + 6] = (cq2 - cd.z) * isc; s1[8 * g + 7] = (cq2 - cd.w) * isc;
          }
        } else {
#pragma unroll
          for (int i = 0; i < 16; ++i) { s0[i] = 0.f; s1[i] = 0.f; }
        }
        __builtin_amdgcn_sched_barrier(0);
        {
          const unsigned char* ka = Ks + pir * 272 + koff_b + h * 16;
#pragma unroll
          for (int ks = 0; ks < KSN; ++ks) {
            const bf16x8 a0 = *(const bf16x8*)(ka + ks * 32);
            const bf16x8 a1 = *(const bf16x8*)(ka + 32 * 272 + ks * 32);
            s0 = MFMA32(a0, bq[ks], s0);
            s1 = MFMA32(a1, bq[ks], s1);
          }
          __builtin_amdgcn_sched_group_barrier(0x100, 6, 0);
#pragma unroll
          for (int i = 0; i < KSN - 3; ++i) {
            __builtin_amdgcn_sched_group_barrier(0x008, 2, 0);
            __builtin_amdgcn_sched_group_barrier(0x100, 2, 0);
          }
          __builtin_amdgcn_sched_group_barrier(0x008, 6, 0);
        }
        __builtin_amdgcn_sched_barrier(0);
      }
      if (tile < tend) {
        const int nb_ = (cur ^ 1);
#pragma unroll
        for (int i = 0; i < 2; ++i) {
          *(u32x4*)(smem + nb_ * KBUF + k_lds + i * 32 * 272) = kreg[i];
          *(u32x4*)(smem + nb_ * VBUF + v_lds + i * 64 * 144) = vreg[i];
        }
      }
      if (act) {
        const bool causal = (kb + 63 > q0w);
        bool lanevalid = true;
        if (MODE == 0) { const int jb = tile >> 2; if (jb < own) lanevalid = (mymask >> jb) & 1; }
        if (causal) {
#pragma unroll
          for (int i = 0; i < 16; ++i) {
            const int key = kb + (i & 7) + 8 * h + 16 * (i >> 3);
            if (key > qrow) s0[i] = kNeg;
            if (key + 32 > qrow) s1[i] = kNeg;
          }
        }
        float mx = fmaxf(s0[0], s1[0]);
#pragma unroll
        for (int i = 1; i < 16; ++i) mx = fmaxf(fmaxf(mx, s0[i]), s1[i]);
        if (MODE == 0) mx = lanevalid ? mx : kNeg;
        {
          const unsigned mu = __float_as_uint(mx);
          const auto sw = __builtin_amdgcn_permlane32_swap(mu, mu, false, false);
          mx = fmaxf(__uint_as_float(sw[0]), __uint_as_float(sw[1]));
        }
        if (__builtin_amdgcn_ballot_w64(mx > m_run + 8.0f * isc) != 0ull) {
          const float m_new = fmaxf(m_run, mx);
          const float alpha = __builtin_amdgcn_exp2f((m_run - m_new) * sc);
          m_run = m_new;
          l_run *= alpha;
#pragma unroll
          for (int d = 0; d < 4; ++d) o[d] *= alpha;
        }
        {
          const float nm = (MODE == 0 && !lanevalid) ? kNeg : -m_run * sc;
          float la = 0.f, lb = 0.f;
#pragma unroll
          for (int i = 0; i < 16; ++i) {
            float a = fmaf(s0[i], sc, nm), b = fmaf(s1[i], sc, nm);
            asm("" : "+v"(a)); asm("" : "+v"(b));
            a = __builtin_amdgcn_exp2f(a); b = __builtin_amdgcn_exp2f(b);
            la += a; lb += b;
            asm("" : "+v"(la)); asm("" : "+v"(lb));
            s0[i] = a; s1[i] = b;
          }
          l_run += la + lb;
        }
        const unsigned char* va = Vs + r * 144 + h * 16;
#pragma unroll
        for (int kk = 0; kk < 4; ++kk) {
          uint4 pu;
          if (kk == 0)      pu = make_uint4(pk2(s0[0], s0[1]), pk2(s0[2], s0[3]), pk2(s0[4], s0[5]), pk2(s0[6], s0[7]));
          else if (kk == 1) pu = make_uint4(pk2(s0[8], s0[9]), pk2(s0[10], s0[11]), pk2(s0[12], s0[13]), pk2(s0[14], s0[15]));
          else if (kk == 2) pu = make_uint4(pk2(s1[0], s1[1]), pk2(s1[2], s1[3]), pk2(s1[4], s1[5]), pk2(s1[6], s1[7]));
          else              pu = make_uint4(pk2(s1[8], s1[9]), pk2(s1[10], s1[11]), pk2(s1[12], s1[13]), pk2(s1[14], s1[15]));
          const bf16x8 pf = __builtin_bit_cast(bf16x8, pu);
#pragma unroll
          for (int d = 0; d < 4; ++d) {
            const bf16x8 vf = *(const bf16x8*)(va + d * 32 * 144 + kk * 32);
            o[d] = MFMA32(vf, pf, o[d]);
          }
        }
      }
      __syncthreads();
    }

    const int te = opaque_tid();
    const int lane_e = te & 63, w_e = te >> 6, r_e = lane_e & 31, h_e = lane_e >> 5;
    const int map_e = (MODE == 2) ? (w_e >> 2) : 0;
    const int qsub_e = (MODE == 2) ? (w_e & 3) : w_e;
    const float ltot = l_run + __shfl_xor(l_run, 32);
    const float inv = 1.0f / ltot;
    unsigned char* Os = smem;
    if (MODE == 2) {
      float* ex = (float*)smem;
      const float* lamp = (const float*)(p.ws + OFF_LAM);
      const float lam = lamp[0], oml = lamp[1];
      if (map_e == 1) {
        const float f = inv * lam;
#pragma unroll
        for (int d = 0; d < 4; ++d)
#pragma unroll
          for (int i = 0; i < 16; ++i) ex[(d * 16 + i) * 256 + qsub_e * 64 + lane_e] = o[d][i] * f;
      }
      __syncthreads();
      if (map_e == 0) {
        float ss = 0.f;
#pragma unroll
        for (int d = 0; d < 4; ++d)
#pragma unroll
          for (int i = 0; i < 16; ++i) {
            const float v = o[d][i] * inv - ex[(d * 16 + i) * 256 + qsub_e * 64 + lane_e];
            o[d][i] = v; ss += v * v;
          }
        ss += __shfl_xor(ss, 32);
        const float rn = rsqrtf(ss * (1.0f / 128.0f) + kEps) * oml;
#pragma unroll
        for (int d = 0; d < 4; ++d)
#pragma unroll
          for (int i = 0; i < 16; ++i) o[d][i] *= rn;
      }
      __syncthreads();
      if (map_e == 0) {
#pragma unroll
        for (int d = 0; d < 4; ++d)
#pragma unroll
          for (int ig = 0; ig < 4; ++ig)
            *(uint2*)(Os + (32 * qsub_e + r_e) * 272 + (32 * d + 8 * ig + 4 * h_e) * 2) =
                make_uint2(pk2(o[d][4 * ig], o[d][4 * ig + 1]), pk2(o[d][4 * ig + 2], o[d][4 * ig + 3]));
      }
    } else {
#pragma unroll
      for (int d = 0; d < 4; ++d)
#pragma unroll
        for (int ig = 0; ig < 4; ++ig)
          *(uint2*)(Os + (32 * qsub_e + r_e) * 272 + (32 * d + 8 * ig + 4 * h_e) * 2) =
              make_uint2(pk2(o[d][4 * ig] * inv, o[d][4 * ig + 1] * inv), pk2(o[d][4 * ig + 2] * inv, o[d][4 * ig + 3] * inv));
    }
    u32x4 gpre[NQ / 32];
    {
      const size_t mrow0 = (size_t)b * kS + q0;
#pragma unroll
      for (int i = 0; i < NQ / 32; ++i) {
        const int u = i * NTHR + te, row = u >> 4, ch = u & 15;
        gpre[i] = *(const u32x4*)(Gg + (mrow0 + row) * 1024 + hd * 128 + ch * 8);
      }
    }
    __syncthreads();
    {
      const size_t mrow0 = (size_t)b * kS + q0;
#pragma unroll
      for (int i = 0; i < NQ / 32; ++i) {
        const int u = i * NTHR + te, row = u >> 4, ch = u & 15;
        const uint4 ov = *(const uint4*)(Os + row * 272 + ch * 16);
        const size_t gi = (mrow0 + row) * 1024 + hd * 128 + ch * 8;
        const uint4 gv = make_uint4(gpre[i][0], gpre[i][1], gpre[i][2], gpre[i][3]);
        float y0 = bf_lo(ov.x) * bf_lo(gv.x), y1 = bf_hi(ov.x) * bf_hi(gv.x);
        float y2 = bf_lo(ov.y) * bf_lo(gv.y), y3 = bf_hi(ov.y) * bf_hi(gv.y);
        float y4 = bf_lo(ov.z) * bf_lo(gv.z), y5 = bf_hi(ov.z) * bf_hi(gv.z);
        float y6 = bf_lo(ov.w) * bf_lo(gv.w), y7 = bf_hi(ov.w) * bf_hi(gv.w);
        if (MODE == 2) {
          const float* sl = (const float*)(p.ws + OFF_CONST) + 1024;
          const float4 ga = *(const float4*)(sl + ch * 8), gb = *(const float4*)(sl + ch * 8 + 4);
          y0 *= ga.x; y1 *= ga.y; y2 *= ga.z; y3 *= ga.w; y4 *= gb.x; y5 *= gb.y; y6 *= gb.z; y7 *= gb.w;
        }
        *(uint4*)(Yg + gi) = make_uint4(pk2(y0, y1), pk2(y2, y3), pk2(y4, y5), pk2(y6, y7));
      }
    }
    if (threadIdx.x == 0) qslot[0] = nxt_w;
    __syncthreads();
  }
}

__global__ void __launch_bounds__(NTHR, 2) mega_fwd(Params p) {
  cg::grid_group grid = cg::this_grid();
  __shared__ __attribute__((aligned(16))) unsigned char smem[SMEM_BYTES];
  __shared__ uint4 xb_words;
  if (threadIdx.x == 0) xb_words = make_uint4(0u, 0u, 0u, 0u);
  __syncthreads();
  if (blockIdx.x == 0) {
    unsigned* bw = (unsigned*)(p.ws + OFF_BAR);
    for (int i = threadIdx.x; i < 4096; i += NTHR) __hip_atomic_store(bw + i, 0u, __ATOMIC_RELAXED, __HIP_MEMORY_SCOPE_AGENT);
  }
  phase_prep(p, smem);
  grid.sync();
  XcdBarrier xb = xcd_barrier_post((unsigned*)(p.ws + OFF_BAR), (volatile LAS unsigned*)&xb_words);
#pragma unroll 1
  for (int layer = 0; layer < 4; ++layer) {
    phase_inproj(p, layer, smem);
    xcd_barrier(xb);
    const int kind = layer % 3;
    if (kind == 0) attn_phase<0>(p, smem, layer);
    else if (kind == 1) attn_phase<1>(p, smem, layer);
    else attn_phase<2>(p, smem, layer);
    xcd_barrier(xb);
    phase_outproj(p, layer, smem);
    if (layer < 3) xcd_barrier(xb);
  }
}

extern "C" void kernel_launch(void* const* d_in, const int* in_sizes, int n_in, void* d_out, int out_size,
                              void* d_ws, size_t ws_size, hipStream_t stream) {
  static int grid_blocks = 0;
  if (!grid_blocks) {
    int dev = 0, cus = 0, per_cu = 0;
    (void)hipGetDevice(&dev);
    (void)hipDeviceGetAttribute(&cus, hipDeviceAttributeMultiprocessorCount, dev);
    (void)hipOccupancyMaxActiveBlocksPerMultiprocessor(&per_cu, mega_fwd, NTHR, 0);
    if (per_cu < 1) per_cu = 1;
    if (per_cu > 1) per_cu = 1;
    grid_blocks = cus * per_cu;
  }
  if (ws_size < WS_NEED) { fprintf(stderr, "workspace too small: %zu < %zu\n", ws_size, (size_t)WS_NEED); return; }
  Params p{};
  p.x = (const float*)d_in[0]; p.norm_g = (const float*)d_in[1]; p.w_out = (const float*)d_in[2];
  p.a_w_in = (const float*)d_in[3]; p.a_q_norm = (const float*)d_in[4]; p.a_k_norm = (const float*)d_in[5];
  p.b_w_in = (const float*)d_in[6]; p.b_f_bias = (const float*)d_in[7]; p.b_q_norm = (const float*)d_in[8]; p.b_k_norm = (const float*)d_in[9];
  p.c_w_in = (const float*)d_in[10]; p.c_q_norm = (const float*)d_in[11]; p.c_k_norm = (const float*)d_in[12];
  p.c_lq1 = (const float*)d_in[13]; p.c_lk1 = (const float*)d_in[14]; p.c_lq2 = (const float*)d_in[15]; p.c_lk2 = (const float*)d_in[16];
  p.c_subln = (const float*)d_in[17];
  p.out = (float*)d_out; p.ws = (unsigned char*)d_ws;
  void* args[] = {&p};
  hipError_t e = hipLaunchCooperativeKernel((void*)mega_fwd, dim3(grid_blocks), dim3(NTHR), args, 0, stream);
  if (e != hipSuccess) fprintf(stderr, "cooperative launch failed: %s (grid %d)\n", hipGetErrorString(e), grid_blocks);
}
```

```cpp
#include <hip/hip_runtime.h>
#include <hip/hip_cooperative_groups.h>
#include <cstdio>
#include <cstdint>
namespace cg = cooperative_groups;

#define DI __device__ __forceinline__
typedef short bf16x8 __attribute__((ext_vector_type(8)));
typedef float f32x16 __attribute__((ext_vector_type(16)));
typedef __bf16 bf2_t __attribute__((ext_vector_type(2)));
typedef float f2_t __attribute__((ext_vector_type(2)));
typedef unsigned short bf16;
typedef unsigned u32x4 __attribute__((ext_vector_type(4)));
typedef float f32x4 __attribute__((ext_vector_type(4)));
#define LAS __attribute__((address_space(3)))

#define MFMA32(a, b, c) __builtin_amdgcn_mfma_f32_32x32x16_bf16((a), (b), (c), 0, 0, 0)

constexpr int kB = 16, kS = 2048, kD = 1024, kH = 8, kM = kB * kS, kNPAD = 4224;
constexpr float kEps = 1e-6f, kLog2e = 1.4426950408889634f;
constexpr float kNeg = -1e30f;

constexpr size_t SZ_ACT    = (size_t)kM * 1024 * 2;
constexpr size_t OFF_WTIN  = 0;
constexpr size_t OFF_WTOUT = OFF_WTIN + (size_t)4 * kNPAD * 1024 * 2;
constexpr size_t OFF_XB    = OFF_WTOUT + (size_t)4 * 1024 * 1024 * 2;
constexpr size_t OFF_Q     = OFF_XB + SZ_ACT;
constexpr size_t OFF_K     = OFF_Q + SZ_ACT;
constexpr size_t OFF_VT    = OFF_K + SZ_ACT;
constexpr size_t OFF_G     = OFF_VT + SZ_ACT;
constexpr size_t OFF_Y     = OFF_G + SZ_ACT;
constexpr size_t OFF_ROWSQ = OFF_Y + SZ_ACT;
constexpr size_t OFF_KPART = OFF_ROWSQ + (size_t)32 * kM * 4;
constexpr size_t OFF_LOGF  = OFF_KPART + (size_t)128 * 16 * 128 * 4;
constexpr size_t OFF_COSH  = OFF_LOGF + (size_t)128 * 2048 * 4;
constexpr size_t OFF_SINH  = OFF_COSH + (size_t)2048 * 64 * 4;
constexpr size_t OFF_COSD  = OFF_SINH + (size_t)2048 * 64 * 4;
constexpr size_t OFF_SIND  = OFF_COSD + (size_t)2048 * 32 * 4;
constexpr size_t OFF_LAM   = OFF_SIND + (size_t)2048 * 32 * 4;
constexpr size_t OFF_CONST = OFF_LAM + 256;
constexpr size_t OFF_BAR   = OFF_CONST + 8192;
constexpr size_t WS_NEED   = OFF_BAR + 16384;

constexpr int SMEM_BYTES = 152576;
constexpr int NTHR = 512;

struct Params {
  const float* x; const float* norm_g; const float* w_out;
  const float* a_w_in; const float* a_q_norm; const float* a_k_norm;
  const float* b_w_in; const float* b_f_bias; const float* b_q_norm; const float* b_k_norm;
  const float* c_w_in; const float* c_q_norm; const float* c_k_norm;
  const float* c_lq1; const float* c_lk1; const float* c_lq2; const float* c_lk2; const float* c_subln;
  float* out; unsigned char* ws;
};

DI unsigned pk2(float a, float b) { f2_t f = {a, b}; bf2_t r = __builtin_convertvector(f, bf2_t); return __builtin_bit_cast(unsigned, r); }
DI float bf_lo(unsigned u) { return __uint_as_float(u << 16); }
DI float bf_hi(unsigned u) { return __uint_as_float(u & 0xffff0000u); }
DI float wave_sum(float v) {
#pragma unroll
  for (int o = 32; o; o >>= 1) v += __shfl_xor(v, o);
  return v;
}


#define XB_TMO      128
#define XB_XCNT(j)  (256  + 64 * (j))
#define XB_XSUB(j)  (1280 + 64 * (j))
#define XB_XGEN(j)  (2304 + 64 * (j))
#define XB_TOP      3328
#define XB_TOPGEN   3392
#define XCD_BAR_WORDS 3456
#define XB_SPIN_CAP (1u << 18)

__device__ __forceinline__ unsigned xb_ld(unsigned* p)              { return __hip_atomic_load(p, __ATOMIC_RELAXED, __HIP_MEMORY_SCOPE_AGENT); }
__device__ __forceinline__ unsigned xb_add(unsigned* p, unsigned v) { return __hip_atomic_fetch_add(p, v, __ATOMIC_RELAXED, __HIP_MEMORY_SCOPE_AGENT); }
__device__ __forceinline__ unsigned xb_xcc_id() { return (unsigned)__builtin_amdgcn_s_getreg((3 << 11) | 20) & 0xFu; }
#define XB_SPIN(cond, bar) do { unsigned _sp = 0; while (cond) { __builtin_amdgcn_s_sleep(1); \
    if ((++_sp & 255u) == 0u) { if (xb_ld(&(bar)[XB_TMO])) break; if (_sp > XB_SPIN_CAP) { atomicAdd(&(bar)[XB_TMO], 1u); break; } } } } while (0)

struct XcdBarrier {
    unsigned* bar; unsigned x;
    volatile LAS unsigned* st;
};

__device__ __forceinline__ XcdBarrier xcd_barrier_post(unsigned* bar, volatile LAS unsigned* st) {
    XcdBarrier b; b.bar = bar; b.x = xb_xcc_id(); b.st = st;
    if (threadIdx.x == 0) (void)xb_add(&bar[XB_XCNT(b.x)], 1u);
    return b;
}
__device__ __forceinline__ void xcd_barrier_complete(unsigned* bar, unsigned x, unsigned& nloc, unsigned& nx) {
    const unsigned G = gridDim.x * gridDim.y * gridDim.z;
    unsigned sum, cnt, mine, sp = 0u;
    for (;;) {
        sum = 0u; cnt = 0u; mine = 0u;
#pragma unroll
        for (unsigned j = 0; j < 16; ++j) { const unsigned c = xb_ld(&bar[XB_XCNT(j)]); sum += c; cnt += (c > 0u) ? 1u : 0u; mine = (j == x) ? c : mine; }
        if (sum == G) break;
        __builtin_amdgcn_s_sleep(1);
        if ((++sp & 255u) == 0u) { if (xb_ld(&bar[XB_TMO])) break; if (sp > XB_SPIN_CAP) { atomicAdd(&bar[XB_TMO], 1u); break; } }
    }
    nloc = mine > 0u ? mine : 1u; nx = cnt > 0u ? cnt : 1u;
}

__device__ __forceinline__ void xcd_barrier(const XcdBarrier& b) {
    asm volatile("s_waitcnt vmcnt(0)" ::: "memory");
    __syncthreads();
    if (threadIdx.x == 0) {
        unsigned* bar = b.bar;
        __builtin_amdgcn_s_waitcnt(0);
        unsigned nloc = b.st[0], nx = b.st[1];
        if (nloc == 0u) { xcd_barrier_complete(bar, b.x, nloc, nx); b.st[0] = nloc; b.st[1] = nx; }
        const unsigned old = xb_add(&bar[XB_XSUB(b.x)], 1u);
        const unsigned gen = old / nloc;
        if (old + 1u == (gen + 1u) * nloc) {
            __builtin_amdgcn_fence(__ATOMIC_RELEASE, "agent");
            asm volatile("s_waitcnt vmcnt(0)" ::: "memory");
            const unsigned og = xb_add(&bar[XB_TOP], 1u);
            const unsigned tg = og / nx;
            if (og + 1u == (tg + 1u) * nx) xb_add(&bar[XB_TOPGEN], 1u);
            else XB_SPIN(xb_ld(&bar[XB_TOPGEN]) == tg, bar);
            __builtin_amdgcn_fence(__ATOMIC_ACQUIRE, "agent");
            xb_add(&bar[XB_XGEN(b.x)], 1u);
            asm volatile("s_waitcnt vmcnt(0)" ::: "memory");
        } else {
            XB_SPIN(xb_ld(&bar[XB_XGEN(b.x)]) == gen, bar);
            __builtin_amdgcn_fence(__ATOMIC_ACQUIRE, "agent");
            asm volatile("s_waitcnt vmcnt(0)" ::: "memory");
        }
    }
    __syncthreads();
}

DI int opaque_tid() { int t = threadIdx.x; asm volatile("" : "+v"(t)); return t; }

DI void phase_prep(const Params& p, unsigned char* smem) {
  const int t = threadIdx.x, lane = t & 63;
  float* tl = (float*)smem;
  const int n_in_tiles = 4 * 16 * 66, n_tiles = n_in_tiles + 4 * 16 * 16;
  for (int tile = blockIdx.x; tile < n_tiles; tile += gridDim.x) {
    const float* W; const float* g; int N, kt, nt; bf16* WT;
    if (tile < n_in_tiles) {
      const int l = tile / 1056, rem = tile % 1056; kt = rem / 66; nt = rem % 66;
      W = (l == 0) ? p.a_w_in : (l == 1) ? p.b_w_in : (l == 2) ? p.c_w_in : p.a_w_in + (size_t)1024 * 4096;
      N = (l == 1) ? 4104 : 4096;
      g = p.norm_g + l * 1024;
      WT = (bf16*)(p.ws + OFF_WTIN) + (size_t)l * kNPAD * 1024;
    } else {
      const int t2 = tile - n_in_tiles; const int l = t2 / 256, rem = t2 % 256; kt = rem / 16; nt = rem % 16;
      W = p.w_out + (size_t)l * 1024 * 1024; N = 1024; g = nullptr;
      WT = (bf16*)(p.ws + OFF_WTOUT) + (size_t)l * 1024 * 1024;
    }
    {
      const int nl = t & 63, n = nt * 64 + nl;
      float wv[8], gv[8];
#pragma unroll
      for (int i = 0; i < 8; ++i) {
        const int k = kt * 64 + i * 8 + (t >> 6);
        wv[i] = (n < N) ? W[(size_t)k * N + n] : 0.f;
        gv[i] = g ? g[k] : 1.f;
      }
#pragma unroll
      for (int i = 0; i < 8; ++i) tl[(i * 8 + (t >> 6)) * 65 + nl] = wv[i] * gv[i];
    }
    __syncthreads();
    {
      const int nl = t >> 3, kc = (t & 7) * 8;
      unsigned u[4];
#pragma unroll
      for (int j = 0; j < 4; ++j) u[j] = pk2(tl[(kc + 2 * j) * 65 + nl], tl[(kc + 2 * j + 1) * 65 + nl]);
      *(uint4*)(WT + (size_t)(nt * 64 + nl) * 1024 + kt * 64 + kc) = make_uint4(u[0], u[1], u[2], u[3]);
    }
    __syncthreads();
  }
  {
    bf16* xb = (bf16*)(p.ws + OFF_XB);
    float* rowsq = (float*)(p.ws + OFF_ROWSQ);
    const int gw = blockIdx.x * 8 + (t >> 6), nw = gridDim.x * 8;
    for (int row0 = gw * 4; row0 < kM; row0 += nw * 4) {
      float4 v[4][4];
#pragma unroll
      for (int rr = 0; rr < 4; ++rr)
#pragma unroll
        for (int i = 0; i < 4; ++i) v[rr][i] = ((const float4*)(p.x + (size_t)(row0 + rr) * 1024))[i * 64 + lane];
#pragma unroll
      for (int rr = 0; rr < 4; ++rr) {
        uint2* xo = (uint2*)(xb + (size_t)(row0 + rr) * 1024);
        float ss = 0.f;
#pragma unroll
        for (int i = 0; i < 4; ++i) {
          const float4 q = v[rr][i];
          ss += q.x * q.x + q.y * q.y + q.z * q.z + q.w * q.w;
          xo[i * 64 + lane] = make_uint2(pk2(q.x, q.y), pk2(q.z, q.w));
        }
        ss = wave_sum(ss);
        if (lane < 32) rowsq[(size_t)lane * kM + row0 + rr] = (lane == 0) ? ss : 0.f;
      }
    }
  }
  {
    float* cosh_ = (float*)(p.ws + OFF_COSH); float* sinh_ = (float*)(p.ws + OFF_SINH);
    float* cosd_ = (float*)(p.ws + OFF_COSD); float* sind_ = (float*)(p.ws + OFF_SIND);
    const int tot = 2048 * 64 + 2048 * 32;
    for (int idx = blockIdx.x * NTHR + t; idx < tot; idx += gridDim.x * NTHR) {
      int pos, fi, half; float* cd; float* sd;
      if (idx < 2048 * 64) { pos = idx >> 6; fi = idx & 63; half = 64; cd = cosh_ + idx; sd = sinh_ + idx; }
      else { const int j = idx - 2048 * 64; pos = j >> 5; fi = j & 31; half = 32; cd = cosd_ + j; sd = sind_ + j; }
      const float inv = (float)exp(-9.210340371976184 * (double)fi / (double)half);
      const float ang = (float)pos * inv;
      const double tt = (double)ang * 0.15915494309189535;
      const double fr = tt - rint(tt);
      const float rr = (float)(fr * 6.283185307179586);
      *cd = cosf(rr); *sd = sinf(rr);
    }
  }
  if (blockIdx.x == 1 && t < 128) {
    float* cst = (float*)(p.ws + OFF_CONST);
    cst[0 * 256 + t] = p.a_q_norm[t];        cst[0 * 256 + 128 + t] = p.a_k_norm[t];
    cst[1 * 256 + t] = p.b_q_norm[t];        cst[1 * 256 + 128 + t] = p.b_k_norm[t];
    cst[2 * 256 + t] = p.c_q_norm[t & 63];   cst[2 * 256 + 128 + t] = p.c_k_norm[t & 63];
    cst[3 * 256 + t] = p.a_q_norm[128 + t];  cst[3 * 256 + 128 + t] = p.a_k_norm[128 + t];
    cst[1024 + t] = p.c_subln[t];
    if (t < 8) cst[1152 + t] = p.b_f_bias[t];
    if (t == 0) {
      float gq = 0.f, gk = 0.f;
      for (int i = 0; i < 128; ++i) { gq = fmaxf(gq, fabsf(p.b_q_norm[i])); gk = fmaxf(gk, fabsf(p.b_k_norm[i])); }
      cst[1160] = 2.0f * 128.0f * gq * gk * 1.02f * (0.08838834764831845f * kLog2e);
    }
  }
  if (blockIdx.x == 0 && t < 64) {
    float a = p.c_lq1[t] * p.c_lk1[t], b = p.c_lq2[t] * p.c_lk2[t];
    a = wave_sum(a); b = wave_sum(b);
    if (t == 0) {
      float* lam = (float*)(p.ws + OFF_LAM);
      const float li = 0.8f - 0.6f * expf(-0.3f * 2.0f);
      lam[0] = expf(a) - expf(b) + li;
      lam[1] = 1.0f - li;
    }
  }
}

constexpr int HTB = 16384;
DI int lds_byte(int r, int c) { const int st = (r >> 4) * 2 + (c >> 5), rr = r & 15, cc = c & 31, ob = rr * 64 + cc * 2; return st * 1024 + (ob ^ (((ob >> 9) & 1) << 5)); }
DI void stage_rc(int b, int& R, int& C) { const int st = b / 1024, sb = b % 1024, swz = sb ^ (((sb >> 9) & 1) << 5); R = (st >> 1) * 16 + swz / 64; C = (st & 1) * 32 + (swz % 64) / 2; }

DI void gemm_unit(const bf16* __restrict__ A, const bf16* __restrict__ Bt, LAS unsigned char* lds, f32x4 (&acc)[2][2][4][2], const int tid) {
  constexpr int K = 1024, nt = 16;
  const int wid = __builtin_amdgcn_readfirstlane(tid >> 6), lane = tid & 63, wr = wid >> 2, wc = wid & 3, fr = lane & 15, fq = lane >> 4;
  unsigned voff[2];
#pragma unroll
  for (int i = 0; i < 2; ++i) { int R, C; stage_rc(tid * 16 + i * 8192, R, C); voff[i] = (unsigned)(R * K + C) * 2u; }
  const size_t kstep = 128, hstep = (size_t)128 * K * 2;
  const unsigned ldsw = (unsigned)wid * 1024u;
  const int aoff = lds_byte(wr * 64 + fr, fq * 8), boff = lds_byte(wc * 32 + fr, fq * 8);
  const char* cA = (const char*)A; const char* cB = (const char*)Bt;
#define G_SA(b, h) (((b) * 2 + (h)) * HTB)
#define G_SB(b, h) ((4 + (b) * 2 + (h)) * HTB)
#define G_STAGE(bufoff, gbase) do { _Pragma("unroll") for (int _i = 0; _i < 2; ++_i) \
    __builtin_amdgcn_global_load_lds((const unsigned*)((const char*)(gbase) + voff[_i]), (LAS unsigned*)(lds + (bufoff) + ldsw + _i * 8192), 16, 0, 0); } while (0)
#define G_LDA(dst, b, h) do { _Pragma("unroll") for (int m = 0; m < 4; ++m) _Pragma("unroll") for (int k = 0; k < 2; ++k) dst[m][k] = *(const LAS bf16x8*)(lds + G_SA(b, h) + aoff + m * 2048 + k * 1024); } while (0)
#define G_LDB(dst, b, h) do { _Pragma("unroll") for (int n = 0; n < 2; ++n) _Pragma("unroll") for (int k = 0; k < 2; ++k) dst[n][k] = *(const LAS bf16x8*)(lds + G_SB(b, h) + boff + n * 2048 + k * 1024); } while (0)
#define G_MMA(ai, bj, At, Bx) do { __builtin_amdgcn_s_setprio(1); _Pragma("unroll") for (int m = 0; m < 4; ++m) _Pragma("unroll") for (int n = 0; n < 2; ++n) _Pragma("unroll") for (int k = 0; k < 2; ++k) \
    acc[ai][bj][m][n] = __builtin_amdgcn_mfma_f32_16x16x32_bf16(Bx[n][k], At[m][k], acc[ai][bj][m][n], 0, 0, 0); __builtin_amdgcn_s_setprio(0); } while (0)
#define G_WAIT_V(n) asm volatile("s_waitcnt vmcnt(" #n ")" ::: "memory")
#define G_WAIT_L(n) asm volatile("s_waitcnt lgkmcnt(" #n ")" ::: "memory")
#define G_BAR __builtin_amdgcn_s_barrier()
#define G_SCHED __builtin_amdgcn_sched_barrier(0)
#pragma unroll
  for (int a = 0; a < 2; ++a)
#pragma unroll
    for (int b = 0; b < 2; ++b)
#pragma unroll
      for (int m = 0; m < 4; ++m)
#pragma unroll
        for (int n = 0; n < 2; ++n) acc[a][b][m][n] = (f32x4){0.f, 0.f, 0.f, 0.f};
  bf16x8 At[4][2], B0[2][2], B1[2][2];
  G_STAGE(G_SB(0, 0), cB); G_STAGE(G_SA(0, 0), cA); G_STAGE(G_SB(0, 1), cB + hstep); G_STAGE(G_SA(0, 1), cA + hstep);
  if (wr == 1) G_BAR;
  G_WAIT_V(4); G_BAR;
  G_STAGE(G_SB(1, 0), cB + kstep); G_STAGE(G_SA(1, 0), cA + kstep); G_STAGE(G_SB(1, 1), cB + hstep + kstep);
  G_WAIT_V(6); G_BAR;
#pragma unroll 1
  for (int t = 0; t < nt - 2; t += 2) {
    const char* a1 = cA + (size_t)(t + 1) * kstep;
    const char* a2 = cA + (size_t)(t + 2) * kstep; const char* b2 = cB + (size_t)(t + 2) * kstep;
    const char* a3 = a2 + kstep; const char* b3 = b2 + kstep;
    G_LDB(B0, 0, 0); G_SCHED; G_LDA(At, 0, 0); G_STAGE(G_SA(1, 1), a1 + hstep);
    G_WAIT_L(8); G_BAR; G_WAIT_L(0); G_MMA(0, 0, At, B0); G_BAR; G_SCHED;
    G_LDB(B1, 0, 1); G_STAGE(G_SB(0, 0), b2);
    G_BAR; G_WAIT_L(0); G_MMA(0, 1, At, B1); G_BAR;
    G_LDA(At, 0, 1); G_STAGE(G_SA(0, 0), a2);
    G_BAR; G_WAIT_L(0); G_MMA(1, 0, At, B0); G_BAR; G_SCHED;
    G_STAGE(G_SB(0, 1), b2 + hstep);
    G_WAIT_V(6); G_BAR; G_MMA(1, 1, At, B1); G_BAR;
    G_LDB(B0, 1, 0); G_SCHED; G_LDA(At, 1, 0); G_STAGE(G_SA(0, 1), a2 + hstep);
    G_WAIT_L(8); G_BAR; G_WAIT_L(0); G_MMA(0, 0, At, B0); G_BAR; G_SCHED;
    G_LDB(B1, 1, 1); G_STAGE(G_SB(1, 0), b3);
    G_BAR; G_WAIT_L(0); G_MMA(0, 1, At, B1); G_BAR;
    G_LDA(At, 1, 1); G_STAGE(G_SA(1, 0), a3);
    G_BAR; G_WAIT_L(0); G_MMA(1, 0, At, B0); G_BAR; G_SCHED;
    G_STAGE(G_SB(1, 1), b3 + hstep);
    G_WAIT_V(6); G_BAR; G_MMA(1, 1, At, B1); G_BAR;
  }
  { G_LDB(B0, 0, 0); G_LDA(At, 0, 0); G_STAGE(G_SA(1, 1), cA + hstep + (size_t)(nt - 1) * kstep);
    G_BAR; G_WAIT_L(0); G_MMA(0, 0, At, B0); G_BAR;
    G_LDB(B1, 0, 1); G_BAR; G_WAIT_L(0); G_MMA(0, 1, At, B1); G_BAR;
    G_LDA(At, 0, 1); G_WAIT_V(4); G_BAR; G_WAIT_L(0); G_MMA(1, 0, At, B0); G_MMA(1, 1, At, B1); G_BAR; }
  { G_LDB(B0, 1, 0); G_LDA(At, 1, 0); G_WAIT_V(2); G_BAR; G_WAIT_L(0); G_MMA(0, 0, At, B0); G_BAR;
    G_LDB(B1, 1, 1); G_WAIT_V(0); G_BAR; G_WAIT_L(0); G_MMA(0, 1, At, B1); G_BAR;
    G_LDA(At, 1, 1); G_BAR; G_WAIT_L(0); G_MMA(1, 0, At, B0); G_MMA(1, 1, At, B1); G_BAR; }
  if (wr == 0) G_BAR;
#undef G_SA
#undef G_SB
#undef G_STAGE
#undef G_LDA
#undef G_LDB
#undef G_MMA
#undef G_WAIT_V
#undef G_WAIT_L
#undef G_BAR
#undef G_SCHED
}

DI bool unit_next(int i, int nM, int nN, int& pm, int& pn) {
  const int nwg = nM * nN;
  const long Lg = (long)i * gridDim.x + blockIdx.x;
  if (Lg >= nwg) return false;
  int wgid = (int)Lg;
  { const int q = nwg / 8, r = nwg % 8, xcd = wgid % 8, off = wgid / 8; wgid = (xcd < r ? xcd * (q + 1) : r * (q + 1) + (xcd - r) * q) + off; }
  const int nig = 8 * nN, gid = wgid / nig, fm = gid * 8, gsz = (nM - fm) < 8 ? (nM - fm) : 8;
  pm = fm + ((wgid % nig) % gsz); pn = (wgid % nig) / gsz;
  return true;
}

DI void sub_to_lds(float* Cs, const f32x4 (&a)[4][2], const int t) {
  const int lane = t & 63, w = t >> 6, wr = w >> 2, wc = w & 3, fr = lane & 15, fq = lane >> 4;
#pragma unroll
  for (int m = 0; m < 4; ++m)
#pragma unroll
    for (int n = 0; n < 2; ++n)
      *(f32x4*)(Cs + (wr * 64 + m * 16 + fr) * 132 + wc * 32 + n * 16 + fq * 4) = a[m][n];
}

DI void sub_to_lds_T(float* Cs, const f32x4 (&a)[4][2], const int t) {
  const int lane = t & 63, w = t >> 6, wr = w >> 2, wc = w & 3, fr = lane & 15, fq = lane >> 4;
#pragma unroll
  for (int m = 0; m < 4; ++m)
#pragma unroll
    for (int n = 0; n < 2; ++n)
#pragma unroll
      for (int j = 0; j < 4; ++j)
        Cs[(wc * 32 + n * 16 + fq * 4 + j) * 132 + wr * 64 + m * 16 + fr] = a[m][n][j];
}

DI float red16(float v) {
  v += __int_as_float(__builtin_amdgcn_update_dpp(0, __float_as_int(v), 0xB1, 0xF, 0xF, true));
  v += __int_as_float(__builtin_amdgcn_update_dpp(0, __float_as_int(v), 0x4E, 0xF, 0xF, true));
  v += __int_as_float(__builtin_amdgcn_update_dpp(0, __float_as_int(v), 0x141, 0xF, 0xF, true));
  v += __int_as_float(__builtin_amdgcn_update_dpp(0, __float_as_int(v), 0x140, 0xF, 0xF, true));
  return v;
}

DI void epi_qk(const float* Cs, const float* rs, const int kind, bf16* dst, const float4 gn, const float4 gp,
               float4 c4, float4 s4, const float4 dc4, const float4 ds4, float* kc, const bool want_kc, const int rg, const int c0) {
  const int dsub = (kind == 2) ? 64 : 128, half = dsub >> 1;
  const int cp = c0 ^ half;
  const float inv_d = 1.0f / (float)dsub;
  const float sg = (c0 & half) ? 1.f : -1.f;
  float cs0 = 0.f, cs1 = 0.f, cs2 = 0.f, cs3 = 0.f;
  float ssv[8];
#pragma unroll
  for (int pass = 0; pass < 8; ++pass) {
    const int row = pass * 16 + rg;
    const float4 v = *(const float4*)(Cs + row * 132 + c0);
    ssv[pass] = v.x * v.x + v.y * v.y + v.z * v.z + v.w * v.w;
  }
#pragma unroll
  for (int pass = 0; pass < 8; ++pass) ssv[pass] = red16(ssv[pass]);
  if (dsub == 128) {
#pragma unroll
    for (int pass = 0; pass < 8; ++pass) ssv[pass] += __shfl_xor(ssv[pass], 16);
  }
#pragma unroll
  for (int pass = 0; pass < 8; ++pass) {
    const int row = pass * 16 + rg;
    const float rr = rs[row];
    const float4 v = *(const float4*)(Cs + row * 132 + c0);
    const float rn = rsqrtf(ssv[pass] * rr * rr * inv_d + kEps) * rr;
    float o0 = v.x * rn * gn.x, o1 = v.y * rn * gn.y, o2 = v.z * rn * gn.z, o3 = v.w * rn * gn.w;
    if (kind != 1) {
      const float4 pv = *(const float4*)(Cs + row * 132 + cp);
      const float pr = rn * sg;
      o0 = o0 * c4.x + pv.x * pr * gp.x * s4.x;
      o1 = o1 * c4.y + pv.y * pr * gp.y * s4.y;
      o2 = o2 * c4.z + pv.z * pr * gp.z * s4.z;
      o3 = o3 * c4.w + pv.w * pr * gp.w * s4.w;
      float tc;
      tc = c4.x * dc4.x - s4.x * ds4.x; s4.x = s4.x * dc4.x + c4.x * ds4.x; c4.x = tc;
      tc = c4.y * dc4.y - s4.y * ds4.y; s4.y = s4.y * dc4.y + c4.y * ds4.y; c4.y = tc;
      tc = c4.z * dc4.z - s4.z * ds4.z; s4.z = s4.z * dc4.z + c4.z * ds4.z; c4.z = tc;
      tc = c4.w * dc4.w - s4.w * ds4.w; s4.w = s4.w * dc4.w + c4.w * ds4.w; c4.w = tc;
    }
    *(uint2*)((unsigned char*)dst + (unsigned)((row * 128 + c0) * 2)) = make_uint2(pk2(o0, o1), pk2(o2, o3));
    cs0 += o0; cs1 += o1; cs2 += o2; cs3 += o3;
  }
  if (want_kc) *(float4*)(kc + rg * 128 + c0) = make_float4(cs0, cs1, cs2, cs3);
}

DI void phase_inproj(const Params& p, int layer, unsigned char* smem) {
  const int kind = layer % 3, jj = layer / 3;
  const bf16* XB = (const bf16*)(p.ws + OFF_XB);
  const bf16* WT = (const bf16*)(p.ws + OFF_WTIN) + (size_t)layer * kNPAD * 1024;
  const float* rowsq = (const float*)(p.ws + OFF_ROWSQ);
  float* CsA = (float*)smem;
  float* CsB = (float*)(smem + 67584);
  float* kcA = (float*)(smem + 135168);
  float* kcB = (float*)(smem + 143360);
  float* rs_all = (float*)(smem + 151552);
  float rs_next = 0.f;
  {
    int pm, pn;
    if (unit_next(0, 128, 16, pm, pn)) {
      const int t0 = opaque_tid();
      float s = 0.f;
#pragma unroll
      for (int j = 0; j < 8; ++j) s += *(const float*)((const unsigned char*)rowsq + (unsigned)((j * kM + pm * 256 + (t0 & 255)) * 4));
      rs_next = rsqrtf(s * (1.0f / 1024.0f) + kEps);
    }
  }
#pragma unroll 1
  for (int ui = 0;; ++ui) {
    int pm, pn;
    if (!unit_next(ui, 128, 16, pm, pn)) break;
    const int t = opaque_tid();
    float my_rs = rs_next;
    f32x4 acc[2][2][4][2];
    gemm_unit(XB + (size_t)pm * 256 * 1024, WT + (size_t)pn * 256 * 1024, (LAS unsigned char*)smem, acc, t);
    const int type = pn >> 2;
    { const int t0 = opaque_tid(); if (t0 < 256) rs_all[t0] = my_rs; }
    if (type == 3) {
      __syncthreads();
      const int tz = opaque_tid();
      const int lane = tz & 63, w = tz >> 6, wr = w >> 2, wc = w & 3, fr = lane & 15, fq = lane >> 4;
      unsigned char* gbase = p.ws + OFF_G + ((size_t)pm * 256 * 1024 + (size_t)((pn * 2) & 7) * 128) * 2;
#pragma unroll
      for (int ai = 0; ai < 2; ++ai)
#pragma unroll
        for (int m = 0; m < 4; ++m) {
          const int rowl = ai * 128 + wr * 64 + m * 16 + fr;
          const float rr = rs_all[rowl];
#pragma unroll
          for (int bj = 0; bj < 2; ++bj)
#pragma unroll
            for (int n = 0; n < 2; ++n) {
              const f32x4 a = acc[ai][bj][m][n] * rr;
              const float g0 = a[0] * __builtin_amdgcn_rcpf(1.f + __builtin_amdgcn_exp2f(-kLog2e * a[0]));
              const float g1 = a[1] * __builtin_amdgcn_rcpf(1.f + __builtin_amdgcn_exp2f(-kLog2e * a[1]));
              const float g2 = a[2] * __builtin_amdgcn_rcpf(1.f + __builtin_amdgcn_exp2f(-kLog2e * a[2]));
              const float g3 = a[3] * __builtin_amdgcn_rcpf(1.f + __builtin_amdgcn_exp2f(-kLog2e * a[3]));
              *(uint2*)(gbase + (unsigned)((rowl * 1024 + bj * 128 + wc * 32 + n * 16 + fq * 4) * 2)) = make_uint2(pk2(g0, g1), pk2(g2, g3));
            }
        }
    } else
#pragma unroll
    for (int ai = 0; ai < 2; ++ai) {
      const int te = opaque_tid();
      const int rg = te >> 5, L = te & 31, c0 = 4 * L;
      const int m0 = pm * 256 + ai * 128;
      const float* rs = rs_all + ai * 128;
      const int b = m0 >> 11, s0 = m0 & 2047;
      float4 gn = make_float4(0.f, 0.f, 0.f, 0.f), gp = gn, c4 = gn, s4 = gn, dc4 = gn, ds4 = gn;
      if (type < 2) {
        const int dsub_ = (kind == 2) ? 64 : 128, half_ = dsub_ >> 1;
        const float* gain = (const float*)(p.ws + OFF_CONST) + layer * 256 + type * 128;
        gn = *(const float4*)(gain + (c0 & (dsub_ - 1)));
        gp = *(const float4*)(gain + ((c0 ^ half_) & (dsub_ - 1)));
        if (kind != 1) {
          const float* cosT = (const float*)(p.ws + ((kind == 2) ? OFF_COSD : OFF_COSH));
          const float* sinT = (const float*)(p.ws + ((kind == 2) ? OFF_SIND : OFF_SINH));
          const int fi_ = c0 & (half_ - 1);
          c4 = *(const float4*)(cosT + (size_t)(s0 + rg) * half_ + fi_);
          s4 = *(const float4*)(sinT + (size_t)(s0 + rg) * half_ + fi_);
          dc4 = *(const float4*)(cosT + (size_t)16 * half_ + fi_);
          ds4 = *(const float4*)(sinT + (size_t)16 * half_ + fi_);
        }
      }
      __syncthreads();
      if (type == 2) { sub_to_lds_T(CsA, acc[ai][0], te); sub_to_lds_T(CsB, acc[ai][1], te); }
      else { sub_to_lds(CsA, acc[ai][0], te); sub_to_lds(CsB, acc[ai][1], te); }
      __syncthreads();
      const int hd0 = (pn * 2) & 7;
      if (type < 2) {
        const bool want_kc = (kind == 0 && type == 1);
        bf16* base = (bf16*)(p.ws + ((type == 0) ? OFF_Q : OFF_K));
        epi_qk(CsA, rs, kind, base + ((size_t)(b * 8 + hd0) * kS + s0) * 128, gn, gp, c4, s4, dc4, ds4, kcA, want_kc, rg, c0);
        epi_qk(CsB, rs, kind, base + ((size_t)(b * 8 + hd0 + 1) * kS + s0) * 128, gn, gp, c4, s4, dc4, ds4, kcB, want_kc, rg, c0);
        if (want_kc) {
          __syncthreads();
          if (te < 256) {
            const float* kc = (te < 128) ? kcA : kcB;
            const int col = te & 127;
            float s = 0.f;
#pragma unroll
            for (int j = 0; j < 16; ++j) s += kc[j * 128 + col];
            float* kpart = (float*)(p.ws + OFF_KPART);
            kpart[((size_t)(b * 8 + hd0 + (te >> 7)) * 16 + (s0 >> 7)) * 128 + col] = s;
          }
        }
      } else if (type == 2) {
        const int tok = 4 * L;
        const float4 r4 = *(const float4*)(rs + tok);
#pragma unroll
        for (int bj = 0; bj < 2; ++bj) {
          const float* Cs = bj ? CsB : CsA;
          unsigned char* dst = p.ws + OFF_VT + ((size_t)(b * 8 + hd0 + bj) * 128 * kS + s0) * 2;
#pragma unroll
          for (int pass = 0; pass < 8; ++pass) {
            const int dv = pass * 16 + rg;
            const float4 a = *(const float4*)(Cs + dv * 132 + tok);
            *(uint2*)(dst + (unsigned)((dv * kS + tok) * 2)) = make_uint2(pk2(a.x * r4.x, a.y * r4.y), pk2(a.z * r4.z, a.w * r4.w));
          }
        }
      } else {
#pragma unroll
        for (int bj = 0; bj < 2; ++bj) {
          const float* Cs = bj ? CsB : CsA;
          bf16* dst = (bf16*)(p.ws + OFF_G) + (size_t)m0 * 1024 + (hd0 + bj) * 128;
#pragma unroll
          for (int pass = 0; pass < 8; ++pass) {
            const int row = pass * 16 + rg;
            const float rr = rs[row];
            float4 v = *(const float4*)(Cs + row * 132 + c0);
            v.x *= rr; v.y *= rr; v.z *= rr; v.w *= rr;
            const float g0 = v.x * __builtin_amdgcn_rcpf(1.f + __builtin_amdgcn_exp2f(-kLog2e * v.x));
            const float g1 = v.y * __builtin_amdgcn_rcpf(1.f + __builtin_amdgcn_exp2f(-kLog2e * v.y));
            const float g2 = v.z * __builtin_amdgcn_rcpf(1.f + __builtin_amdgcn_exp2f(-kLog2e * v.z));
            const float g3 = v.w * __builtin_amdgcn_rcpf(1.f + __builtin_amdgcn_exp2f(-kLog2e * v.w));
            *(uint2*)(dst + (size_t)row * 1024 + c0) = make_uint2(pk2(g0, g1), pk2(g2, g3));
          }
        }
      }
    }
    {
      int pm2, pn2;
      if (unit_next(ui + 1, 128, 16, pm2, pn2)) {
        const int tn = opaque_tid();
        float s = 0.f;
#pragma unroll
        for (int j = 0; j < 8; ++j) s += *(const float*)((const unsigned char*)rowsq + (unsigned)((j * kM + pm2 * 256 + (tn & 255)) * 4));
        rs_next = rsqrtf(s * (1.0f / 1024.0f) + kEps);
      }
    }
    __syncthreads();
  }
  if (kind == 1) {
    const int t = opaque_tid();
    const int lane = t & 63, w = t >> 6, fr = lane & 15, fq = lane >> 4;
    float* logf = (float*)(p.ws + OFF_LOGF);
    for (int task = blockIdx.x * 8 + w; task < kM / 16; task += gridDim.x * 8) {
      const int row0 = task * 16;
      const bf16* ap = XB + (size_t)(row0 + fr) * 1024 + fq * 8;
      const bf16* bp = WT + (size_t)(4096 + fr) * 1024 + fq * 8;
      f32x4 c = (f32x4){0.f, 0.f, 0.f, 0.f};
#pragma unroll 8
      for (int ks = 0; ks < 32; ++ks) {
        const bf16x8 a = *(const bf16x8*)(ap + ks * 32);
        const bf16x8 bb = *(const bf16x8*)(bp + ks * 32);
        c = __builtin_amdgcn_mfma_f32_16x16x32_bf16(a, bb, c, 0, 0, 0);
      }
      if (fr < 8) {
        const float bias = ((const float*)(p.ws + OFF_CONST))[1152 + fr];
#pragma unroll
        for (int j = 0; j < 4; ++j) {
          const int m = row0 + fq * 4 + j;
          float s = 0.f;
#pragma unroll
          for (int q = 0; q < 8; ++q) s += rowsq[(size_t)q * kM + m];
          const float rr = rsqrtf(s * (1.0f / 1024.0f) + kEps);
          const float f = c[j] * rr + bias;
          const float lf = fminf(f, 0.f) - log1pf(expf(-fabsf(f)));
          logf[(size_t)((m >> 11) * 8 + fr) * kS + (m & 2047)] = lf;
        }
      }
    }
  }
}

DI void phase_outproj(const Params& p, int layer, unsigned char* smem) {
  const bf16* Y = (const bf16*)(p.ws + OFF_Y);
  const bf16* WT = (const bf16*)(p.ws + OFF_WTOUT) + (size_t)layer * 1024 * 1024;
  const float* xold = (layer == 0) ? p.x : p.out;
  float* CsA = (float*)smem;
  float* CsB = (float*)(smem + 67584);
#pragma unroll 1
  for (int ui = 0;; ++ui) {
    int pm, pn;
    if (!unit_next(ui, 128, 4, pm, pn)) break;
    const int t = opaque_tid();
    f32x4 acc[2][2][4][2];
    gemm_unit(Y + (size_t)pm * 256 * 1024, WT + (size_t)pn * 256 * 1024, (LAS unsigned char*)smem, acc, t);
#pragma unroll
    for (int ai = 0; ai < 2; ++ai) {
      const int te = opaque_tid();
      const int rg = te >> 5, L = te & 31, c0 = 4 * L;
      const int m0 = pm * 256 + ai * 128;
      const unsigned char* xbase = (const unsigned char*)(xold + (size_t)m0 * 1024 + pn * 256);
      unsigned char* obase = (unsigned char*)(p.out + (size_t)m0 * 1024 + pn * 256);
      unsigned char* bbase = p.ws + OFF_XB + ((size_t)m0 * 1024 + pn * 256) * 2;
      float* rsq = (float*)(p.ws + OFF_ROWSQ) + m0;
      f32x4 xpre[8];
#pragma unroll
      for (int pass = 0; pass < 8; ++pass) xpre[pass] = *(const f32x4*)(xbase + (unsigned)(((pass * 16 + rg) * 1024 + c0) * 4));
      __syncthreads();
      sub_to_lds(CsA, acc[ai][0], te);
      sub_to_lds(CsB, acc[ai][1], te);
      __syncthreads();
#pragma unroll
      for (int bj = 0; bj < 2; ++bj) {
        const float* Cs = bj ? CsB : CsA;
        const int nt = pn * 2 + bj;
        f32x4 xnext[8];
        if (bj == 0) {
#pragma unroll
          for (int pass = 0; pass < 8; ++pass) xnext[pass] = *(const f32x4*)(xbase + (unsigned)(((pass * 16 + rg) * 1024 + 128 + c0) * 4));
        }
        float ssv[8];
#pragma unroll
        for (int pass = 0; pass < 8; ++pass) {
          const int row = pass * 16 + rg;
          const unsigned off = (unsigned)(row * 1024 + bj * 128 + c0);
          const f32x4 c = *(const f32x4*)(Cs + row * 132 + c0);
          const f32x4 xn = xpre[pass] + c;
          *(f32x4*)(obase + off * 4u) = xn;
          if (layer < 3) {
            *(uint2*)(bbase + off * 2u) = make_uint2(pk2(xn[0], xn[1]), pk2(xn[2], xn[3]));
            ssv[pass] = xn[0] * xn[0] + xn[1] * xn[1] + xn[2] * xn[2] + xn[3] * xn[3];
          }
        }
        if (layer < 3) {
#pragma unroll
          for (int pass = 0; pass < 8; ++pass) ssv[pass] = red16(ssv[pass]);
#pragma unroll
          for (int pass = 0; pass < 8; ++pass) {
            const float tot = ssv[pass] + __shfl_xor(ssv[pass], 16);
            if (L == 0) rsq[(size_t)nt * kM + pass * 16 + rg] = tot;
          }
        }
        if (bj == 0) {
#pragma unroll
          for (int pass = 0; pass < 8; ++pass) xpre[pass] = xnext[pass];
        }
      }
    }
    __syncthreads();
  }
}

template <int MODE>
DI void attn_phase(const Params& p, unsigned char* smem, const int layer) {
  constexpr int NQ = (MODE == 2) ? 128 : 256;
  constexpr int NQB = kS / NQ;
  constexpr int KSN = (MODE == 2) ? 4 : 8;
  const bf16* Qg = (const bf16*)(p.ws + OFF_Q);
  const bf16* Kg = (const bf16*)(p.ws + OFF_K);
  const bf16* VTg = (const bf16*)(p.ws + OFF_VT);
  const bf16* Gg = (const bf16*)(p.ws + OFF_G);
  bf16* Yg = (bf16*)(p.ws + OFF_Y);
  constexpr int KBUF = 17408, VBUF = 18432, VOFF = 2 * KBUF;
  float* cs = (float*)(smem + 71680);
  float* kmean = cs;
  int* sel = (int*)(smem + 79872);
  float* wtot = (float*)(smem + 80896);
  const float sc = ((MODE == 2) ? 0.125f : 0.08838834764831845f) * kLog2e;
  const float isc = 1.0f / sc;
  const int total = 128 * NQB, G = gridDim.x;

  unsigned* qctr = (unsigned*)(p.ws + OFF_BAR) + 3584 + layer * 64;
  int* qslot = (int*)(smem + SMEM_BYTES - 16);
  (void)G;
  if (threadIdx.x == 0) qslot[0] = (int)atomicAdd(qctr, 1u);
  __syncthreads();
#pragma unroll 1
  for (;;) {
    const int wi = qslot[0];
    if (wi >= total) break;
    int nxt_w = 0;
    if (threadIdx.x == 0) nxt_w = (int)atomicAdd(qctr, 1u);
    const int t = opaque_tid();
    const int lane = t & 63, w = t >> 6, r = lane & 31, h = lane >> 5;
    const int map = (MODE == 2) ? (w >> 2) : 0;
    const int qsub = (MODE == 2) ? (w & 3) : w;
    const int pir = (r & ~12) | ((r & 4) << 1) | ((r & 8) >> 1);
    const int koff_b = (MODE == 2) ? map * 128 : 0;
    const int qb = NQB - 1 - (wi >> 7), bh = wi & 127, b = bh >> 3, hd = bh & 7;
    const int q0 = qb * NQ;
    const int q0w = q0 + 32 * qsub;
    const int qrow = q0w + r;

    bf16x8 bq[KSN];
    {
      const bf16* qp = Qg + ((size_t)bh * kS + qrow) * 128 + ((MODE == 2) ? map * 64 : 0) + 8 * h;
#pragma unroll
      for (int ks = 0; ks < KSN; ++ks) bq[ks] = *(const bf16x8*)(qp + 16 * ks);
    }

    float cq2 = 0.f;
    int j0 = 0;
    int mymask = 0;
    int own = 0;
    if (MODE == 1) {
      const int nel = q0 + NQ;
      const float* lf = (const float*)(p.ws + OFF_LOGF) + (size_t)bh * kS;
      float v0 = 0.f, v1 = 0.f, v2 = 0.f, v3 = 0.f;
      const int base = t * 4;
      if (base < nel) { const float4 a = *(const float4*)(lf + base); v0 = a.x; v1 = a.y; v2 = a.z; v3 = a.w; }
      v1 += v0; v2 += v1; v3 += v2;
      const float tot = v3;
      float inc = tot;
#pragma unroll
      for (int o = 1; o < 64; o <<= 1) { const float y = __shfl_up(inc, o); if (lane >= o) inc += y; }
      if (lane == 63) wtot[w] = inc;
      __syncthreads();
      float off = inc - tot;
#pragma unroll
      for (int ww = 0; ww < 7; ++ww) if (ww < w) off += wtot[ww];
      if (base < nel) *(float4*)(cs + base) = make_float4((off + v0) * kLog2e, (off + v1) * kLog2e, (off + v2) * kLog2e, (off + v3) * kLog2e);
      __syncthreads();
      cq2 = cs[qrow];
      if (t < 64) {
        const float twoB = ((const float*)(p.ws + OFF_CONST))[1160];
        const int tl_ = t & 31;
        const int last = (q0 + NQ - 1) >> 6;
        const bool sk = (tl_ <= last) && (twoB + cs[q0] - cs[64 * tl_ + 63] < -152.0f);
        const unsigned long long bal = __builtin_amdgcn_ballot_w64(sk);
        const unsigned lowm = (unsigned)(bal & 0xffffffffull);
        if (t == 0) sel[0] = (lowm == 0xffffffffu) ? 0 : __builtin_ctz(~lowm);
      }
      __syncthreads();
      j0 = sel[0];
    }
    if (MODE == 0) {
      own = qb;
      if (own > 3) {
        const float* kpart = (const float*)(p.ws + OFF_KPART) + (size_t)bh * 16 * 128;
        {
          const int d = t & 127;
#pragma unroll
          for (int i = 0; i < 2; ++i) {
            const int nb = (t >> 7) + 4 * i;
            if (nb < own) kmean[nb * 128 + d] = (kpart[(2 * nb) * 128 + d] + kpart[(2 * nb + 1) * 128 + d]) * (1.0f / 256.0f);
          }
        }
        __syncthreads();
        const int qi = t >> 1, hf = t & 1;
        const bf16* qp = Qg + ((size_t)bh * kS + q0 + qi) * 128 + hf * 64;
        float ga[7];
#pragma unroll
        for (int nb = 0; nb < 7; ++nb) ga[nb] = 0.f;
#pragma unroll 2
        for (int c = 0; c < 8; ++c) {
          const uint4 qv = *(const uint4*)(qp + c * 8);
          float qf[8];
          qf[0] = bf_lo(qv.x); qf[1] = bf_hi(qv.x); qf[2] = bf_lo(qv.y); qf[3] = bf_hi(qv.y);
          qf[4] = bf_lo(qv.z); qf[5] = bf_hi(qv.z); qf[6] = bf_lo(qv.w); qf[7] = bf_hi(qv.w);
#pragma unroll
          for (int nb = 0; nb < 7; ++nb) {
            if (nb < own) {
              const float* km = kmean + nb * 128 + hf * 64 + c * 8;
#pragma unroll
              for (int e = 0; e < 8; ++e) ga[nb] += qf[e] * km[e];
            }
          }
        }
        int mask = 0;
#pragma unroll
        for (int nb = 0; nb < 7; ++nb) ga[nb] += __shfl_xor(ga[nb], 1);
#pragma unroll
        for (int pick = 0; pick < 3; ++pick) {
          float best = -3.0e38f; int bi = 0;
#pragma unroll
          for (int nb = 0; nb < 7; ++nb) {
            const bool ok = (nb < own) && !((mask >> nb) & 1) && (ga[nb] > best);
            if (ok) { best = ga[nb]; bi = nb; }
          }
          mask |= (1 << bi);
        }
        if (hf == 0) sel[qi] = mask;
      } else {
        if (t < 256) sel[t] = (1 << own) - 1;
      }
      __syncthreads();
      mymask = sel[32 * qsub + r];
    }

    const int tend = (q0 + NQ - 1) >> 6;
    const unsigned char* kg = (const unsigned char*)(Kg + (size_t)bh * kS * 128);
    const unsigned char* vg = (const unsigned char*)(VTg + (size_t)bh * 128 * kS);
    u32x4 kreg[2], vreg[2];
    const int k_lds = (t >> 4) * 272 + (t & 15) * 16;
    const int v_lds = VOFF + (t >> 3) * 144 + (t & 7) * 16;
    const unsigned k_go = (unsigned)t * 16u;
    const unsigned v_go = (unsigned)(t >> 3) * 4096u + (unsigned)(t & 7) * 16u;
#pragma unroll
    for (int i = 0; i < 2; ++i) {
      kreg[i] = *(const u32x4*)(kg + (size_t)j0 * 16384 + (k_go + i * 8192u));
      vreg[i] = *(const u32x4*)(vg + (size_t)j0 * 128 + (v_go + i * 262144u));
    }
#pragma unroll
    for (int i = 0; i < 2; ++i) {
      *(u32x4*)(smem + (j0 & 1) * KBUF + k_lds + i * 32 * 272) = kreg[i];
      *(u32x4*)(smem + (j0 & 1) * VBUF + v_lds + i * 64 * 144) = vreg[i];
    }
    __syncthreads();

    f32x16 o[4];
#pragma unroll
    for (int d = 0; d < 4; ++d)
#pragma unroll
      for (int i = 0; i < 16; ++i) o[d][i] = 0.f;
    float m_run = kNeg, l_run = 0.f;

#pragma unroll 2
    for (int tile = j0; tile <= tend; ++tile) {
      const int cur = tile & 1;
      if (tile < tend) {
#pragma unroll
        for (int i = 0; i < 2; ++i) {
          kreg[i] = *(const u32x4*)(kg + (size_t)(tile + 1) * 16384 + (k_go + i * 8192u));
          vreg[i] = *(const u32x4*)(vg + (size_t)(tile + 1) * 128 + (v_go + i * 262144u));
        }
      }
      const int kb = tile * 64;
      const bool act = (kb <= q0w + 31);
      const unsigned char* Ks = smem + cur * KBUF;
      const unsigned char* Vs = smem + VOFF + cur * VBUF;
      f32x16 s0, s1;
      if (act) {
        if (MODE == 1) {
#pragma unroll
          for (int g = 0; g < 2; ++g) {
            const float4 ca = *(const float4*)(cs + kb + 8 * h + 16 * g);
            const float4 cb = *(const float4*)(cs + kb + 8 * h + 16 * g + 4);
            s0[8 * g + 0] = (cq2 - ca.x) * isc; s0[8 * g + 1] = (cq2 - ca.y) * isc; s0[8 * g + 2] = (cq2 - ca.z) * isc; s0[8 * g + 3] = (cq2 - ca.w) * isc;
            s0[8 * g + 4] = (cq2 - cb.x) * isc; s0[8 * g + 5] = (cq2 - cb.y) * isc; s0[8 * g + 6] = (cq2 - cb.z) * isc; s0[8 * g + 7] = (cq2 - cb.w) * isc;
            const float4 cc = *(const float4*)(cs + kb + 32 + 8 * h + 16 * g);
            const float4 cd = *(const float4*)(cs + kb + 32 + 8 * h + 16 * g + 4);
            s1[8 * g + 0] = (cq2 - cc.x) * isc; s1[8 * g + 1] = (cq2 - cc.y) * isc; s1[8 * g + 2] = (cq2 - cc.z) * isc; s1[8 * g + 3] = (cq2 - cc.w) * isc;
            s1[8 * g + 4] = (cq2 - cd.x) * isc; s1[8 * g + 5] = (cq2 - cd.y) * isc; s1[8 * g + 6] = (cq2 - cd.z) * isc; s1[8 * g + 7] = (cq2 - cd.w) * isc;
          }
        } else {
#pragma unroll
          for (int i = 0; i < 16; ++i) { s0[i] = 0.f; s1[i] = 0.f; }
        }
        __builtin_amdgcn_sched_barrier(0);
        {
          const unsigned char* ka = Ks + pir * 272 + koff_b + h * 16;
#pragma unroll
          for (int ks = 0; ks < KSN; ++ks) {
            const bf16x8 a0 = *(const bf16x8*)(ka + ks * 32);
            const bf16x8 a1 = *(const bf16x8*)(ka + 32 * 272 + ks * 32);
            s0 = MFMA32(a0, bq[ks], s0);
            s1 = MFMA32(a1, bq[ks], s1);
          }
          __builtin_amdgcn_sched_group_barrier(0x100, 6, 0);
#pragma unroll
          for (int i = 0; i < KSN - 3; ++i) {
            __builtin_amdgcn_sched_group_barrier(0x008, 2, 0);
            __builtin_amdgcn_sched_group_barrier(0x100, 2, 0);
          }
          __builtin_amdgcn_sched_group_barrier(0x008, 6, 0);
        }
        __builtin_amdgcn_sched_barrier(0);
      }
      if (tile < tend) {
        const int nb_ = (cur ^ 1);
#pragma unroll
        for (int i = 0; i < 2; ++i) {
          *(u32x4*)(smem + nb_ * KBUF + k_lds + i * 32 * 272) = kreg[i];
          *(u32x4*)(smem + nb_ * VBUF + v_lds + i * 64 * 144) = vreg[i];
        }
      }
      if (act) {
        const bool causal = (kb + 63 > q0w);
        bool lanevalid = true;
        if (MODE == 0) { const int jb = tile >> 2; if (jb < own) lanevalid = (mymask >> jb) & 1; }
        if (causal) {
#pragma unroll
          for (int i = 0; i < 16; ++i) {
            const int key = kb + (i & 7) + 8 * h + 16 * (i >> 3);
            if (key > qrow) s0[i] = kNeg;
            if (key + 32 > qrow) s1[i] = kNeg;
          }
        }
        float mx = fmaxf(s0[0], s1[0]);
#pragma unroll
        for (int i = 1; i < 16; ++i) mx = fmaxf(fmaxf(mx, s0[i]), s1[i]);
        if (MODE == 0) mx = lanevalid ? mx : kNeg;
        {
          const unsigned mu = __float_as_uint(mx);
          const auto sw = __builtin_amdgcn_permlane32_swap(mu, mu, false, false);
          mx = fmaxf(__uint_as_float(sw[0]), __uint_as_float(sw[1]));
        }
        if (__builtin_amdgcn_ballot_w64(mx > m_run + 8.0f * isc) != 0ull) {
          const float m_new = fmaxf(m_run, mx);
          const float alpha = __builtin_amdgcn_exp2f((m_run - m_new) * sc);
          m_run = m_new;
          l_run *= alpha;
#pragma unroll
          for (int d = 0; d < 4; ++d) o[d] *= alpha;
        }
        {
          const float nm = (MODE == 0 && !lanevalid) ? kNeg : -m_run * sc;
          float la = 0.f, lb = 0.f;
#pragma unroll
          for (int i = 0; i < 16; ++i) {
            float a = fmaf(s0[i], sc, nm), b = fmaf(s1[i], sc, nm);
            asm("" : "+v"(a)); asm("" : "+v"(b));
            a = __builtin_amdgcn_exp2f(a); b = __builtin_amdgcn_exp2f(b);
            la += a; lb += b;
            asm("" : "+v"(la)); asm("" : "+v"(lb));
            s0[i] = a; s1[i] = b;
          }
          l_run += la + lb;
        }
        const unsigned char* va = Vs + r * 144 + h * 16;
#pragma unroll
        for (int kk = 0; kk < 4; ++kk) {
          uint4 pu;
          if (kk == 0)      pu = make_uint4(pk2(s0[0], s0[1]), pk2(s0[2], s0[3]), pk2(s0[4], s0[5]), pk2(s0[6], s0[7]));
          else if (kk == 1) pu = make_uint4(pk2(s0[8], s0[9]), pk2(s0[10], s0[11]), pk2(s0[12], s0[13]), pk2(s0[14], s0[15]));
          else if (kk == 2) pu = make_uint4(pk2(s1[0], s1[1]), pk2(s1[2], s1[3]), pk2(s1[4], s1[5]), pk2(s1[6], s1[7]));
          else              pu = make_uint4(pk2(s1[8], s1[9]), pk2(s1[10], s1[11]), pk2(s1[12], s1[13]), pk2(s1[14], s1[15]));
          const bf16x8 pf = __builtin_bit_cast(bf16x8, pu);
#pragma unroll
          for (int d = 0; d < 4; ++d) {
            const bf16x8 vf = *(const bf16x8*)(va + d * 32 * 144 + kk * 32);
            o[d] = MFMA32(vf, pf, o[d]);
          }
        }
      }
      __syncthreads();
    }

    const int te = opaque_tid();
    const int lane_e = te & 63, w_e = te >> 6, r_e = lane_e & 31, h_e = lane_e >> 5;
    const int map_e = (MODE == 2) ? (w_e >> 2) : 0;
    const int qsub_e = (MODE == 2) ? (w_e & 3) : w_e;
    const float ltot = l_run + __shfl_xor(l_run, 32);
    const float inv = 1.0f / ltot;
    unsigned char* Os = smem;
    if (MODE == 2) {
      float* ex = (float*)smem;
      const float* lamp = (const float*)(p.ws + OFF_LAM);
      const float lam = lamp[0], oml = lamp[1];
      if (map_e == 1) {
        const float f = inv * lam;
#pragma unroll
        for (int d = 0; d < 4; ++d)
#pragma unroll
          for (int i = 0; i < 16; ++i) ex[(d * 16 + i) * 256 + qsub_e * 64 + lane_e] = o[d][i] * f;
      }
      __syncthreads();
      if (map_e == 0) {
        float ss = 0.f;
#pragma unroll
        for (int d = 0; d < 4; ++d)
#pragma unroll
          for (int i = 0; i < 16; ++i) {
            const float v = o[d][i] * inv - ex[(d * 16 + i) * 256 + qsub_e * 64 + lane_e];
            o[d][i] = v; ss += v * v;
          }
        ss += __shfl_xor(ss, 32);
        const float rn = rsqrtf(ss * (1.0f / 128.0f) + kEps) * oml;
#pragma unroll
        for (int d = 0; d < 4; ++d)
#pragma unroll
          for (int i = 0; i < 16; ++i) o[d][i] *= rn;
      }
      __syncthreads();
      if (map_e == 0) {
#pragma unroll
        for (int d = 0; d < 4; ++d)
#pragma unroll
          for (int ig = 0; ig < 4; ++ig)
            *(uint2*)(Os + (32 * qsub_e + r_e) * 272 + (32 * d + 8 * ig + 4 * h_e) * 2) =
                make_uint2(pk2(o[d][4 * ig], o[d][4 * ig + 1]), pk2(o[d][4 * ig + 2], o[d][4 * ig + 3]));
      }
    } else {
#pragma unroll
      for (int d = 0; d < 4; ++d)
#pragma unroll
        for (int ig = 0; ig < 4; ++ig)
          *(uint2*)(Os + (32 * qsub_e + r_e) * 272 + (32 * d + 8 * ig + 4 * h_e) * 2) =
              make_uint2(pk2(o[d][4 * ig] * inv, o[d][4 * ig + 1] * inv), pk2(o[d][4 * ig + 2] * inv, o[d][4 * ig + 3] * inv));
    }
    u32x4 gpre[NQ / 32];
    {
      const size_t mrow0 = (size_t)b * kS + q0;
#pragma unroll
      for (int i = 0; i < NQ / 32; ++i) {
        const int u = i * NTHR + te, row = u >> 4, ch = u & 15;
        gpre[i] = *(const u32x4*)(Gg + (mrow0 + row) * 1024 + hd * 128 + ch * 8);
      }
    }
    __syncthreads();
    {
      const size_t mrow0 = (size_t)b * kS + q0;
#pragma unroll
      for (int i = 0; i < NQ / 32; ++i) {
        const int u = i * NTHR + te, row = u >> 4, ch = u & 15;
        const uint4 ov = *(const uint4*)(Os + row * 272 + ch * 16);
        const size_t gi = (mrow0 + row) * 1024 + hd * 128 + ch * 8;
        const uint4 gv = make_uint4(gpre[i][0], gpre[i][1], gpre[i][2], gpre[i][3]);
        float y0 = bf_lo(ov.x) * bf_lo(gv.x), y1 = bf_hi(ov.x) * bf_hi(gv.x);
        float y2 = bf_lo(ov.y) * bf_lo(gv.y), y3 = bf_hi(ov.y) * bf_hi(gv.y);
        float y4 = bf_lo(ov.z) * bf_lo(gv.z), y5 = bf_hi(ov.z) * bf_hi(gv.z);
        float y6 = bf_lo(ov.w) * bf_lo(gv.w), y7 = bf_hi(ov.w) * bf_hi(gv.w);
        if (MODE == 2) {
          const float* sl = (const float*)(p.ws + OFF_CONST) + 1024;
          const float4 ga = *(const float4*)(sl + ch * 8), gb = *(const float4*)(sl + ch * 8 + 4);
          y0 *= ga.x; y1 *= ga.y; y2 *= ga.z; y3 *= ga.w; y4 *= gb.x; y5 *= gb.y; y6 *= gb.z; y7 *= gb.w;
        }
        *(uint4*)(Yg + gi) = make_uint4(pk2(y0, y1), pk2(y2, y3), pk2(y4, y5), pk2(y6, y7));
      }
    }
    if (threadIdx.x == 0) qslot[0] = nxt_w;
    __syncthreads();
  }
}

__global__ void __launch_bounds__(NTHR, 2) mega_fwd(Params p) {
  cg::grid_group grid = cg::this_grid();
  __shared__ __attribute__((aligned(16))) unsigned char smem[SMEM_BYTES];
  __shared__ uint4 xb_words;
  if (threadIdx.x == 0) xb_words = make_uint4(0u, 0u, 0u, 0u);
  __syncthreads();
  if (blockIdx.x == 0) {
    unsigned* bw = (unsigned*)(p.ws + OFF_BAR);
    for (int i = threadIdx.x; i < 4096; i += NTHR) __hip_atomic_store(bw + i, 0u, __ATOMIC_RELAXED, __HIP_MEMORY_SCOPE_AGENT);
  }
  phase_prep(p, smem);
  grid.sync();
  XcdBarrier xb = xcd_barrier_post((unsigned*)(p.ws + OFF_BAR), (volatile LAS unsigned*)&xb_words);
#pragma unroll 1
  for (int layer = 0; layer < 4; ++layer) {
    phase_inproj(p, layer, smem);
    xcd_barrier(xb);
    const int kind = layer % 3;
    if (kind == 0) attn_phase<0>(p, smem, layer);
    else if (kind == 1) attn_phase<1>(p, smem, layer);
    else attn_phase<2>(p, smem, layer);
    xcd_barrier(xb);
    phase_outproj(p, layer, smem);
    if (layer < 3) xcd_barrier(xb);
  }
}

extern "C" void kernel_launch(void* const* d_in, const int* in_sizes, int n_in, void* d_out, int out_size,
                              void* d_ws, size_t ws_size, hipStream_t stream) {
  static int grid_blocks = 0;
  if (!grid_blocks) {
    int dev = 0, cus = 0, per_cu = 0;
    (void)hipGetDevice(&dev);
    (void)hipDeviceGetAttribute(&cus, hipDeviceAttributeMultiprocessorCount, dev);
    (void)hipOccupancyMaxActiveBlocksPerMultiprocessor(&per_cu, mega_fwd, NTHR, 0);
    if (per_cu < 1) per_cu = 1;
    if (per_cu > 1) per_cu = 1;
    grid_blocks = cus * per_cu;
  }
  if (ws_size < WS_NEED) { fprintf(stderr, "workspace too small: %zu < %zu\n", ws_size, (size_t)WS_NEED); return; }
  Params p{};
  p.x = (const float*)d_in[0]; p.norm_g = (const float*)d_in[1]; p.w_out = (const float*)d_in[2];
  p.a_w_in = (const float*)d_in[3]; p.a_q_norm = (const float*)d_in[4]; p.a_k_norm = (const float*)d_in[5];
  p.b_w_in = (const float*)d_in[6]; p.b_f_bias = (const float*)d_in[7]; p.b_q_norm = (const float*)d_in[8]; p.b_k_norm = (const float*)d_in[9];
  p.c_w_in = (const float*)d_in[10]; p.c_q_norm = (const float*)d_in[11]; p.c_k_norm = (const float*)d_in[12];
  p.c_lq1 = (const float*)d_in[13]; p.c_lk1 = (const float*)d_in[14]; p.c_lq2 = (const float*)d_in[15]; p.c_lk2 = (const float*)d_in[16];
  p.c_subln = (const float*)d_in[17];
  p.out = (float*)d_out; p.ws = (unsigned char*)d_ws;
  void* args[] = {&p};
  hipError_t e = hipLaunchCooperativeKernel((void*)mega_fwd, dim3(grid_blocks), dim3(NTHR), args, 0, stream);
  if (e != hipSuccess) fprintf(stderr, "cooperative launch failed: %s (grid %d)\n", hipGetErrorString(e), grid_blocks);
}
```
